# Optimizing an MI355X kernel written in HIP

```python
import math
import jax, jax.numpy as jnp
from jax import lax
import numpy as np


D_MODEL = 1024
BATCH = 4
SEQ = 8192
DEPTH = 2

ATTN_HEADS = 4
ATTN_QK_DIM = 64
ATTN_V_DIM = 2 * ATTN_QK_DIM
ATTN_WIDTH = ATTN_HEADS * ATTN_V_DIM
QK_COLS = ATTN_HEADS * ATTN_QK_DIM
Q_BLOCK = 128
CONV_WIDTH = D_MODEL // 4
CONV_KERNEL = 31
SSM_WIDTH = D_MODEL // 4
SSM_GROUP = 16
SSM_GROUPS = SSM_WIDTH // SSM_GROUP
SSM_STATE = 64
MIX_WIDTH = ATTN_WIDTH + CONV_WIDTH + SSM_WIDTH
IN_COLS = 4 * QK_COLS + ATTN_WIDTH + 2 * CONV_WIDTH + SSM_WIDTH
REL_BUCKETS = 32
REL_MAX_EXACT = REL_BUCKETS // 2
REL_MAX_DIST = 128
N_EXPERT_GROUPS = 4
EXPERTS_PER_GROUP = 8
N_EXPERTS = N_EXPERT_GROUPS * EXPERTS_PER_GROUP
TOP_K_IN_GROUP = 2
EXPERT_FF = D_MODEL // 2
MOE_BLOCK = 256
RMS_EPS = 1e-6
LN_EPS = 1e-5

kernel_name = "hymba_diffattn_conformer_s5_hmoe"


def rms_norm(x, g):
    xf = x.astype(jnp.float32)
    y = xf * lax.rsqrt(jnp.mean(xf * xf, axis=-1, keepdims=True) + RMS_EPS)
    return (y * g.astype(jnp.float32)).astype(x.dtype)


def layer_norm(x, g, b):
    xf = x.astype(jnp.float32)
    mu = jnp.mean(xf, axis=-1, keepdims=True)
    var = jnp.mean(jnp.square(xf - mu), axis=-1, keepdims=True)
    y = (xf - mu) * lax.rsqrt(var + LN_EPS)
    return (y * g.astype(jnp.float32) + b.astype(jnp.float32)).astype(x.dtype)


def rel_bucket(rel):
    n = jnp.maximum(rel, 0)
    nf = jnp.maximum(n, 1).astype(jnp.float32)
    large = REL_MAX_EXACT + (jnp.log(nf / REL_MAX_EXACT) / math.log(REL_MAX_DIST / REL_MAX_EXACT)
                             * (REL_BUCKETS - REL_MAX_EXACT)).astype(jnp.int32)
    large = jnp.minimum(large, REL_BUCKETS - 1)
    return jnp.where(n < REL_MAX_EXACT, n, large)


def diff_attention(q1, q2, k1, k2, v, lam, rel_table):
    B, L, H, dk = q1.shape
    n_blk = L // Q_BLOCK
    scale = dk ** -0.5
    kpos = jnp.arange(L)

    def block(i):
        start = i * Q_BLOCK
        q1b = lax.dynamic_slice_in_dim(q1, start, Q_BLOCK, axis=1)
        q2b = lax.dynamic_slice_in_dim(q2, start, Q_BLOCK, axis=1)
        rel = (start + jnp.arange(Q_BLOCK))[:, None] - kpos[None, :]
        bias = jnp.transpose(rel_table[rel_bucket(rel)], (2, 0, 1)).astype(jnp.float32)
        causal = rel >= 0

        def probs(qb, k):
            s = jnp.einsum('bqhd,bkhd->bhqk', qb, k).astype(jnp.float32) * scale + bias
            return jax.nn.softmax(jnp.where(causal, s, -1e30), axis=-1)

        p = probs(q1b, k1) - lam * probs(q2b, k2)
        return jnp.einsum('bhqk,bkhd->bqhd', p.astype(v.dtype), v)

    out = lax.map(block, jnp.arange(n_blk))
    return jnp.moveaxis(out, 0, 1).reshape(B, L, H, v.shape[-1])


def conformer_conv(u, conv_w, conv_b, ln_g, ln_b):
    a, gate = jnp.split(u, 2, axis=-1)
    h = a * jax.nn.sigmoid(gate)
    h = lax.conv_general_dilated(h, conv_w[:, None, :], window_strides=(1,),
                                 padding=[(CONV_KERNEL - 1, 0)],
                                 dimension_numbers=('NWC', 'WIO', 'NWC'),
                                 feature_group_count=CONV_WIDTH) + conv_b
    h = layer_norm(h, ln_g, ln_b)
    return jax.nn.silu(h)


def _ssm_combine(e1, e2):
    ar1, ai1, br1, bi1 = e1
    ar2, ai2, br2, bi2 = e2
    ar = ar2 * ar1 - ai2 * ai1
    ai = ar2 * ai1 + ai2 * ar1
    br = ar2 * br1 - ai2 * bi1 + br2
    bi = ar2 * bi1 + ai2 * br1 + bi2
    return (ar, ai, br, bi)


def s5_ssm(u, lam_re, lam_im, log_dt, b_re, b_im, c_re, c_im, d, glu_w, glu_b):
    f32 = jnp.float32
    Bsz, L, _ = u.shape
    uf = u.astype(f32).reshape(Bsz, L, SSM_GROUPS, SSM_GROUP)
    dt = jnp.exp(log_dt.astype(f32))[:, None]
    lr, li = lam_re.astype(f32), lam_im.astype(f32)
    mag = jnp.exp(lr * dt)
    ar, ai = mag * jnp.cos(li * dt), mag * jnp.sin(li * dt)
    den = lr * lr + li * li
    zr = ((ar - 1.0) * lr + ai * li) / den
    zi = (ai * lr - (ar - 1.0) * li) / den
    bre, bim = b_re.astype(f32), b_im.astype(f32)
    bbr = zr[..., None] * bre - zi[..., None] * bim
    bbi = zr[..., None] * bim + zi[..., None] * bre
    bu_re = jnp.einsum('blgh,gph->blgp', uf, bbr)
    bu_im = jnp.einsum('blgh,gph->blgp', uf, bbi)
    a_re = jnp.broadcast_to(ar, (1, L, SSM_GROUPS, SSM_STATE))
    a_im = jnp.broadcast_to(ai, (1, L, SSM_GROUPS, SSM_STATE))
    _, _, x_re, x_im = lax.associative_scan(_ssm_combine, (a_re, a_im, bu_re, bu_im), axis=1)
    y = (jnp.einsum('blgp,ghp->blgh', x_re, c_re.astype(f32))
         - jnp.einsum('blgp,ghp->blgh', x_im, c_im.astype(f32))
         + uf * d.astype(f32).reshape(SSM_GROUPS, SSM_GROUP))
    g = jax.nn.gelu(y.reshape(Bsz, L, SSM_WIDTH))
    out = g * jax.nn.sigmoid(g @ glu_w.astype(f32) + glu_b.astype(f32))
    return out.astype(u.dtype)


def hierarchical_moe(h, gw, gb, ew, eb, w_gate, w_up, w_down):
    f32 = jnp.float32
    T, D = h.shape
    g_logits = (h @ gw).astype(f32) + gb.astype(f32)
    g_prob = jax.nn.softmax(g_logits, axis=-1)
    g_idx = jnp.argmax(g_logits, axis=-1)
    g_p = jnp.take_along_axis(g_prob, g_idx[:, None], axis=1)
    e_logits = ((h @ ew).astype(f32) + eb.astype(f32)).reshape(T, N_EXPERT_GROUPS, EXPERTS_PER_GROUP)
    e_logits = jnp.take_along_axis(e_logits, g_idx[:, None, None], axis=1)[:, 0]
    top_v, top_i = lax.top_k(e_logits, TOP_K_IN_GROUP)
    gate = g_p * jax.nn.softmax(top_v, axis=-1)
    expert = g_idx[:, None].astype(jnp.int32) * EXPERTS_PER_GROUP + top_i.astype(jnp.int32)
    S = T * TOP_K_IN_GROUP
    flat_e = expert.reshape(S)
    flat_tok = jnp.repeat(jnp.arange(T, dtype=jnp.int32), TOP_K_IN_GROUP)
    flat_w = gate.reshape(S)
    order = jnp.argsort(flat_e)
    se, st, sw = flat_e[order], flat_tok[order], flat_w[order]
    counts = jnp.bincount(flat_e, length=N_EXPERTS)
    padded = (counts + MOE_BLOCK - 1) // MOE_BLOCK * MOE_BLOCK
    start = jnp.cumsum(counts) - counts
    pend = jnp.cumsum(padded)
    pstart = pend - padded
    dest = pstart[se] + jnp.arange(S) - start[se]
    n_blocks = -(-S // MOE_BLOCK) + N_EXPERTS
    P = n_blocks * MOE_BLOCK
    tok_pad = jnp.full((P,), T, jnp.int32).at[dest].set(st)
    w_pad = jnp.zeros((P,), f32).at[dest].set(sw)
    blk_e = jnp.minimum(jnp.searchsorted(pend, jnp.arange(n_blocks) * MOE_BLOCK, side='right'),
                        N_EXPERTS - 1)
    h_ext = jnp.concatenate([h, jnp.zeros((1, D), h.dtype)], axis=0)

    def expert_block(args):
        tok, e = args
        xb = h_ext[tok]
        act = jax.nn.silu(xb @ w_gate[e]) * (xb @ w_up[e])
        return act @ w_down[e]

    yb = lax.map(expert_block, (tok_pad.reshape(n_blocks, MOE_BLOCK), blk_e))
    yb = yb.reshape(P, D) * w_pad[:, None].astype(h.dtype)
    return jnp.zeros((T + 1, D), h.dtype).at[tok_pad].add(yb)[:T]


def setup_inputs(seed: int = 0) -> dict:
    key = jax.random.key(seed)
    ks = iter(jax.random.split(key, 48))
    f32 = jnp.float32

    def nrm(shape, scale):
        return scale * jax.random.normal(next(ks), shape, f32)

    G, P, H = SSM_GROUPS, SSM_STATE, SSM_GROUP
    n_idx = jnp.arange(P, dtype=f32)
    return {
        "x": nrm((BATCH, SEQ, D_MODEL), 1.0),
        "rel_bias": nrm((REL_BUCKETS, ATTN_HEADS), 0.1),
        "ln1_g": 1.0 + nrm((DEPTH, D_MODEL), 0.02),
        "w_in": nrm((DEPTH, D_MODEL, IN_COLS), D_MODEL ** -0.5),
        "lam_q1": nrm((DEPTH, ATTN_QK_DIM), 0.1),
        "lam_k1": nrm((DEPTH, ATTN_QK_DIM), 0.1),
        "lam_q2": nrm((DEPTH, ATTN_QK_DIM), 0.1),
        "lam_k2": nrm((DEPTH, ATTN_QK_DIM), 0.1),
        "subln_g": 1.0 + nrm((DEPTH, ATTN_V_DIM), 0.02),
        "conv_w": nrm((DEPTH, CONV_KERNEL, CONV_WIDTH), CONV_KERNEL ** -0.5),
        "conv_b": nrm((DEPTH, CONV_WIDTH), 0.02),
        "conv_ln_g": 1.0 + nrm((DEPTH, CONV_WIDTH), 0.02),
        "conv_ln_b": nrm((DEPTH, CONV_WIDTH), 0.02),
        "ssm_lam_re": -0.5 + nrm((DEPTH, G, P), 0.01),
        "ssm_lam_im": math.pi * n_idx + nrm((DEPTH, G, P), 0.01),
        "ssm_log_dt": jax.random.uniform(next(ks), (DEPTH, G), f32, math.log(1e-3), math.log(1e-1)),
        "ssm_b_re": nrm((DEPTH, G, P, H), (2 * H) ** -0.5),
        "ssm_b_im": nrm((DEPTH, G, P, H), (2 * H) ** -0.5),
        "ssm_c_re": nrm((DEPTH, G, H, P), P ** -0.5),
        "ssm_c_im": nrm((DEPTH, G, H, P), P ** -0.5),
        "ssm_d": nrm((DEPTH, SSM_WIDTH), 1.0),
        "ssm_glu_w": nrm((DEPTH, SSM_WIDTH, SSM_WIDTH), SSM_WIDTH ** -0.5),
        "ssm_glu_b": nrm((DEPTH, SSM_WIDTH), 0.02),
        "w_out": nrm((DEPTH, MIX_WIDTH, D_MODEL), MIX_WIDTH ** -0.5),
        "ln2_g": 1.0 + nrm((DEPTH, D_MODEL), 0.02),
        "group_router_w": nrm((DEPTH, D_MODEL, N_EXPERT_GROUPS), D_MODEL ** -0.5),
        "group_router_b": nrm((DEPTH, N_EXPERT_GROUPS), 0.01),
        "expert_router_w": nrm((DEPTH, D_MODEL, N_EXPERTS), D_MODEL ** -0.5),
        "expert_router_b": nrm((DEPTH, N_EXPERTS), 0.01),
        "w_gate": nrm((DEPTH, N_EXPERTS, D_MODEL, EXPERT_FF), D_MODEL ** -0.5),
        "w_up": nrm((DEPTH, N_EXPERTS, D_MODEL, EXPERT_FF), D_MODEL ** -0.5),
        "w_down": nrm((DEPTH, N_EXPERTS, EXPERT_FF, D_MODEL), EXPERT_FF ** -0.5),
        "final_g": 1.0 + nrm((D_MODEL,), 0.02),
    }


def reference(x, rel_bias, ln1_g, w_in, lam_q1, lam_k1, lam_q2, lam_k2, subln_g,
              conv_w, conv_b, conv_ln_g, conv_ln_b,
              ssm_lam_re, ssm_lam_im, ssm_log_dt, ssm_b_re, ssm_b_im, ssm_c_re, ssm_c_im,
              ssm_d, ssm_glu_w, ssm_glu_b, w_out, ln2_g,
              group_router_w, group_router_b, expert_router_w, expert_router_b,
              w_gate, w_up, w_down, final_g):
    B, L, D = x.shape
    splits = np.cumsum([QK_COLS, QK_COLS, QK_COLS, QK_COLS, ATTN_WIDTH, 2 * CONV_WIDTH]).tolist()
    for l in range(DEPTH):
        h = rms_norm(x, ln1_g[l])
        proj = h @ w_in[l]
        q1, q2, k1, k2, v, conv_in, ssm_in = jnp.split(proj, splits, axis=-1)
        q1, q2, k1, k2 = (t.reshape(B, L, ATTN_HEADS, ATTN_QK_DIM) for t in (q1, q2, k1, k2))
        v = v.reshape(B, L, ATTN_HEADS, ATTN_V_DIM)
        lam_init = 0.8 - 0.6 * math.exp(-0.3 * l)
        lam = (jnp.exp(jnp.sum(lam_q1[l].astype(jnp.float32) * lam_k1[l].astype(jnp.float32)))
               - jnp.exp(jnp.sum(lam_q2[l].astype(jnp.float32) * lam_k2[l].astype(jnp.float32)))
               + lam_init)
        a = diff_attention(q1, q2, k1, k2, v, lam, rel_bias)
        a = (rms_norm(a, subln_g[l]) * (1.0 - lam_init)).reshape(B, L, ATTN_WIDTH)
        c = conformer_conv(conv_in, conv_w[l], conv_b[l], conv_ln_g[l], conv_ln_b[l])
        s = s5_ssm(ssm_in, ssm_lam_re[l], ssm_lam_im[l], ssm_log_dt[l], ssm_b_re[l], ssm_b_im[l],
                   ssm_c_re[l], ssm_c_im[l], ssm_d[l], ssm_glu_w[l], ssm_glu_b[l])
        x = x + jnp.concatenate([a, c, s], axis=-1) @ w_out[l]
        h2 = rms_norm(x, ln2_g[l]).reshape(B * L, D)
        x = x + hierarchical_moe(h2, group_router_w[l], group_router_b[l], expert_router_w[l],
                                 expert_router_b[l], w_gate[l], w_up[l], w_down[l]).reshape(B, L, D)
    return rms_norm(x, final_g)
```

```cpp
#include <hip/hip_runtime.h>
#include <hip/hip_cooperative_groups.h>
#include <cstdio>
#include <cstdint>
namespace cg = cooperative_groups;
#define MK_ONE_LAUNCH 0

constexpr int DM = 1024, NB = 4, SEQ = 8192, NTOK = NB * SEQ, DEPTH = 2;
constexpr int NCOL = 2304;
constexpr int COL_Q = 0, COL_K = 512, COL_V = 1024, COL_CONV = 1536, COL_SSM = 2048;
constexpr int NE = 32, FF = 512, MOEB = 256, NSLOTB = 288, PSLOTS = NSLOTB * MOEB;
constexpr int SSM_LC = 32, SSM_NCH = SEQ / SSM_LC;
constexpr float RMS_EPS = 1e-6f, LN_EPS_C = 1e-5f;
constexpr float LOG2E = 1.4426950408889634f;
constexpr float QSCALE = 0.125f * LOG2E;

constexpr size_t MiB = 1u << 20;
constexpr size_t WS_CTL = 0, CTL_ZERO_BYTES = 1 * MiB;
constexpr size_t WS_WIN = 2 * MiB;
constexpr size_t WS_WOUT = 11 * MiB;
constexpr size_t WS_WGLU = 15 * MiB;
constexpr size_t WS_WRT = 16 * MiB;
constexpr size_t WS_WGU = 17 * MiB;
constexpr size_t WS_WDN = 145 * MiB;
constexpr size_t WS_XB = 209 * MiB;
constexpr size_t WS_PROJ = 273 * MiB;
constexpr size_t WS_MIX = 417 * MiB;
constexpr size_t WS_SSM = 481 * MiB;
constexpr size_t WS_ACT = WS_PROJ;
constexpr size_t WS_Y = WS_PROJ + 72 * MiB;
constexpr size_t WS_MISC = 489 * MiB;
constexpr size_t MS_ROWSS = WS_MISC;
constexpr size_t MS_TOKE = MS_ROWSS + 128 * 1024;
constexpr size_t MS_TOKW = MS_TOKE + 256 * 1024;
constexpr size_t MS_RS2 = MS_TOKW + 256 * 1024;
constexpr size_t MS_SLOT = MS_RS2 + 128 * 1024;
constexpr size_t MS_RSSLOT = MS_SLOT + 256 * 1024;
constexpr size_t MS_WSLOT = MS_RSSLOT + 288 * 1024;
constexpr size_t MS_SSMP = MS_WSLOT + 288 * 1024;
constexpr int SP_AR = 0, SP_AI = 1024, SP_ARL = 2048, SP_AIL = 3072, SP_BBR = 4096, SP_BBI = 4096 + 16384, SP_END = 4096 + 32768;
constexpr size_t MS_SSMC = MS_SSMP + 2 * SP_END * 4;
constexpr size_t MS_LUT = MS_SSMC + 2 * 16 * 16 * 128 * 2;
constexpr size_t MS_LAM = MS_LUT + 4 * 132 * 4;
constexpr size_t WS_END = 497 * MiB;
static_assert(MS_LAM + 64 <= WS_END, "misc region");
constexpr int CW_BAR = 4096;
constexpr int CW_CNT = 16384;
constexpr int CW_CUR = 16384 + 64;
constexpr int CW_NUSED = 16384 + 128;
constexpr int CW_BLKE = 16384 + 256;

constexpr int RING_OFF = 0, RING_BYTES = 131072;
constexpr int LDSCTL_OFF = RING_BYTES, MISC_OFF = LDSCTL_OFF + 320;
constexpr int LUT_OFF = MISC_OFF + 128;
constexpr int LDS_BYTES = 147456;
static_assert(LUT_OFF + 132 * 4 <= LDS_BYTES, "LDS map");
namespace pg8 {
#define PG8_LAS __attribute__((address_space(3)))
typedef unsigned short bf16_t;
typedef short bf16x8 __attribute__((ext_vector_type(8)));
typedef float f32x4 __attribute__((ext_vector_type(4)));
typedef unsigned u32x4 __attribute__((ext_vector_type(4)));
constexpr int BM = 256, BK = 64, HALF = 128, HTB = HALF * BK * 2  , STAGE_BYTES = 8 * HTB, NXCD = 8, WGM = 8;

__host__ __device__ __forceinline__ int lds_byte(int r, int c) { const int st = (r >> 4) * 2 + (c >> 5), rr = r & 15, cc = c & 31, ob = rr * 64 + cc * 2; return st * 1024 + (ob ^ (((ob >> 9) & 1) << 5)); }
__host__ __device__ __forceinline__ void stage_rc(int b, int& R, int& C) { const int st = b / 1024, sb = b % 1024, swz = sb ^ (((sb >> 9) & 1) << 5); R = (st >> 1) * 16 + swz / 64; C = (st & 1) * 32 + (swz % 64) / 2; }
__host__ __device__ __forceinline__ int perm32(int rho) { const int n = rho >> 4, i = rho & 15; return 8 * (i >> 2) + 4 * n + (i & 3); }

struct Unit { int pm, pn, e; };
struct Gemm { const bf16_t* A; const bf16_t* Bt; int M, N, K; size_t bstride; };

struct StaticOrder {
    int nM, nN, nwg, G, c;
    __host__ __device__ void init(int M, int N, int G_, int c_) { nM = M / BM; nN = N / BM; nwg = nM * nN; G = G_; c = c_; }
    __host__ __device__ bool next(int i, Unit& u) const {
        const long L = (long)i * G + c; if (L >= nwg) return false;
        int wgid = (int)L; { const int q = nwg / NXCD, r = nwg % NXCD, xcd = wgid % NXCD, off = wgid / NXCD; wgid = (xcd < r ? xcd * (q + 1) : r * (q + 1) + (xcd - r) * q) + off; }
        const int nig = WGM * nN, gid = wgid / nig, fm = gid * WGM, gsz = (nM - fm) < WGM ? (nM - fm) : WGM;
        u.pm = fm + ((wgid % nig) % gsz); u.pn = (wgid % nig) / gsz; u.e = 0; return true;
    }
    __device__ __forceinline__ void a_ready(const Unit&) const {}
    __device__ __forceinline__ void done(const Unit&) const {}
};


typedef float f32x2e __attribute__((ext_vector_type(2))); typedef __bf16 bf16x2e __attribute__((ext_vector_type(2))); typedef unsigned u32x2 __attribute__((ext_vector_type(2)));
__device__ __forceinline__ unsigned pk_bf16(float lo, float hi) { f32x2e v = {lo, hi}; bf16x2e b = __builtin_convertvector(v, bf16x2e); return __builtin_bit_cast(unsigned, b); }
__device__ __forceinline__ u32x4 pk8(const f32x4& v0, const f32x4& v1) { u32x4 w; w.x = pk_bf16(v0[0], v0[1]); w.y = pk_bf16(v0[2], v0[3]); w.z = pk_bf16(v1[0], v1[1]); w.w = pk_bf16(v1[2], v1[3]); return w; }

struct EpiProj {
    static constexpr bool PERM = true, AFTER_DRAIN = false;
    bf16_t* O; const float* rowss;
    __device__ __forceinline__ void operator()(const f32x4 (&acc)[2][2][4][2], const Unit& u, int wr, int wc, int fr, int fq) const {
        const int row0 = u.pm * BM + wr * 64 + fr, col0 = u.pn * BM + wc * 32 + 8 * fq;
        const float cs = (u.pn < 2) ? QSCALE : 1.0f;
#pragma unroll
        for (int ai = 0; ai < 2; ++ai)
#pragma unroll
            for (int m = 0; m < 4; ++m) { const int row = row0 + ai * HALF + m * 16; const float rs = __builtin_amdgcn_rsqf(rowss[row] * (1.0f / 1024.0f) + RMS_EPS) * cs;
                bf16_t* rowp = O + (size_t)row * NCOL + col0;
#pragma unroll
                for (int bj = 0; bj < 2; ++bj) { const f32x4 v0 = acc[ai][bj][m][0] * rs, v1 = acc[ai][bj][m][1] * rs; *(u32x4*)(rowp + bj * HALF) = pk8(v0, v1); } }
    }
};
struct EpiResid {
    static constexpr bool PERM = false, AFTER_DRAIN = false;
    const float* base; float* X; bf16_t* XB;
    __device__ __forceinline__ void operator()(const f32x4 (&acc)[2][2][4][2], const Unit& u, int wr, int wc, int fr, int fq) const {
        const int row0 = u.pm * BM + wr * 64 + fr, col0 = u.pn * BM + wc * 32 + 4 * fq;
#pragma unroll
        for (int ai = 0; ai < 2; ++ai)
#pragma unroll
            for (int m = 0; m < 4; ++m) { const size_t off = (size_t)(row0 + ai * HALF + m * 16) * DM + col0;
#pragma unroll
                for (int bj = 0; bj < 2; ++bj)
#pragma unroll
                    for (int n = 0; n < 2; ++n) { const size_t o2 = off + bj * HALF + n * 16; const f32x4 o = *(const f32x4*)(base + o2) + acc[ai][bj][m][n];
                        *(f32x4*)(X + o2) = o; u32x2 w; w.x = pk_bf16(o[0], o[1]); w.y = pk_bf16(o[2], o[3]); *(u32x2*)(XB + o2) = w; } }
    }
};
struct EpiGateUp {
    static constexpr bool PERM = true, AFTER_DRAIN = false;
    bf16_t* ACT; const float* rs_slot;
    __device__ __forceinline__ void operator()(const f32x4 (&acc)[2][2][4][2], const Unit& u, int wr, int wc, int fr, int fq) const {
        const int row0 = u.pm * BM + wr * 64 + fr, col0 = u.pn * HALF + wc * 32 + 8 * fq;
#pragma unroll
        for (int ai = 0; ai < 2; ++ai)
#pragma unroll
            for (int m = 0; m < 4; ++m) { const int row = row0 + ai * HALF + m * 16; const float rs = rs_slot[row]; f32x4 a[2];
#pragma unroll
                for (int n = 0; n < 2; ++n) { const f32x4 g = acc[ai][0][m][n] * rs, up = acc[ai][1][m][n] * rs;
#pragma unroll
                    for (int j = 0; j < 4; ++j) a[n][j] = g[j] * __builtin_amdgcn_rcpf(1.0f + __builtin_amdgcn_exp2f(-LOG2E * g[j])) * up[j]; }
                *(u32x4*)(ACT + (size_t)row * FF + col0) = pk8(a[0], a[1]); }
    }
};
struct EpiDown {
    static constexpr bool PERM = true, AFTER_DRAIN = false;
    bf16_t* Y; const float* w_slot;
    __device__ __forceinline__ void operator()(const f32x4 (&acc)[2][2][4][2], const Unit& u, int wr, int wc, int fr, int fq) const {
        const int row0 = u.pm * BM + wr * 64 + fr, col0 = u.pn * BM + wc * 32 + 8 * fq;
#pragma unroll
        for (int ai = 0; ai < 2; ++ai)
#pragma unroll
            for (int m = 0; m < 4; ++m) { const int row = row0 + ai * HALF + m * 16; const float ws = w_slot[row]; bf16_t* rowp = Y + (size_t)row * DM + col0;
#pragma unroll
                for (int bj = 0; bj < 2; ++bj) { const f32x4 v0 = acc[ai][bj][m][0] * ws, v1 = acc[ai][bj][m][1] * ws; *(u32x4*)(rowp + bj * HALF) = pk8(v0, v1); } }
    }
};
struct GroupedOrder {
    int nwg, nN, G, c; const int* blk_e;
    __device__ void init(int n_used, int nN_, int G_, int c_, const int* be) { nN = nN_; nwg = n_used * nN_; G = G_; c = c_; blk_e = be; }
    __device__ bool next(int i, Unit& u) const { const long L = (long)i * G + c; if (L >= nwg) return false; u.pm = (int)(L / nN); u.pn = (int)(L % nN); u.e = blk_e[u.pm]; return true; }
    __device__ __forceinline__ void a_ready(const Unit&) const {}
    __device__ __forceinline__ void done(const Unit&) const {}
};
template <class Epi, class Sched, bool ALIGN_EPI = false, bool SP2 = false>
__device__ __forceinline__ void gemm_phase(PG8_LAS unsigned char* lds, const Gemm g, const Sched& S, const Epi& E) {
    int tid_ = threadIdx.x; asm volatile("" : "+v"(tid_));
    const int tid = tid_, wid = __builtin_amdgcn_readfirstlane(tid >> 6), lane = tid & 63, wr = wid >> 2, wc = wid & 3, fr = lane & 15, fq = lane >> 4;
    const int K = g.K, nt = K / BK;
    unsigned voffA[2], voffB[2];
#pragma unroll
    for (int i = 0; i < 2; ++i) { int R, C; stage_rc(tid * 16 + i * 8192, R, C); const int Rb = Epi::PERM ? ((R & ~31) + perm32(R & 31)) : R;
        voffA[i] = (unsigned)(R * K + C) * 2u; voffB[i] = (unsigned)(Rb * K + C) * 2u; }
    const size_t kstep = (size_t)(BK * 2);
    const size_t hstep = (size_t)HALF * K * 2;
    const size_t tstep = 2 * hstep;
    const unsigned ldsw = (unsigned)wid * 1024u;
    const int aoff = lds_byte(wr * 64 + fr, fq * 8), boff = lds_byte(wc * 32 + fr, fq * 8);
#define PG8_SA(b, h) (((b) * 2 + (h)) * HTB)
#define PG8_SB(b, h) ((4 + (b) * 2 + (h)) * HTB)
#define PG8_STAGE(bufoff, gbase, voff) do { _Pragma("unroll") for (int _i = 0; _i < 2; ++_i) \
        __builtin_amdgcn_global_load_lds((const unsigned*)((const char*)(gbase) + (voff)[_i]), (PG8_LAS unsigned*)(lds + (bufoff) + ldsw + _i * 8192), 16, 0, 0); } while (0)
#define PG8_LDA(dst, b, h) do { _Pragma("unroll") for (int m = 0; m < 4; ++m) _Pragma("unroll") for (int k = 0; k < 2; ++k) dst[m][k] = *(const PG8_LAS bf16x8*)(lds + PG8_SA(b, h) + aoff + m * 2048 + k * 1024); } while (0)
#define PG8_LDB(dst, b, h) do { _Pragma("unroll") for (int n = 0; n < 2; ++n) _Pragma("unroll") for (int k = 0; k < 2; ++k) dst[n][k] = *(const PG8_LAS bf16x8*)(lds + PG8_SB(b, h) + boff + n * 2048 + k * 1024); } while (0)
#define PG8_MMA(ai, bj, At, Bt) do { __builtin_amdgcn_s_setprio(1); _Pragma("unroll") for (int m = 0; m < 4; ++m) _Pragma("unroll") for (int n = 0; n < 2; ++n) _Pragma("unroll") for (int k = 0; k < 2; ++k) \
        acc[ai][bj][m][n] = __builtin_amdgcn_mfma_f32_16x16x32_bf16(Bt[n][k], At[m][k], acc[ai][bj][m][n], 0, 0, 0); __builtin_amdgcn_s_setprio(0); } while (0)
#define PG8_WAIT_V(n) asm volatile("s_waitcnt vmcnt(" #n ")" ::: "memory")
#define PG8_WAIT_L(n) asm volatile("s_waitcnt lgkmcnt(" #n ")" ::: "memory")
#define PG8_BAR __builtin_amdgcn_s_barrier()
#define PG8_SCHED __builtin_amdgcn_sched_barrier(0)
    Unit cur, nxt; int ui = 0;
    if (!S.next(0, cur)) return;
    f32x4 acc[2][2][4][2];
#pragma unroll
    for (int a = 0; a < 2; ++a)
#pragma unroll
        for (int b = 0; b < 2; ++b)
#pragma unroll
            for (int m = 0; m < 4; ++m)
#pragma unroll
                for (int n = 0; n < 2; ++n) acc[a][b][m][n] = (f32x4){0.f, 0.f, 0.f, 0.f};
    bf16x8 At[4][2], B0[2][2], B1[2][2];
    const char* cA = (const char*)g.A + (size_t)cur.pm * tstep; const char* cB = (const char*)g.Bt + (size_t)cur.e * g.bstride + (size_t)cur.pn * tstep;
    S.a_ready(cur);
    if constexpr (SP2) {
        PG8_STAGE(PG8_SB(0, 0), cB, voffB); PG8_STAGE(PG8_SB(0, 1), cB + hstep, voffB); PG8_STAGE(PG8_SA(0, 0), cA, voffA); PG8_STAGE(PG8_SA(0, 1), cA + hstep, voffA);
        if (wr == 1) PG8_BAR;
        PG8_WAIT_V(2); PG8_BAR;
        PG8_STAGE(PG8_SB(1, 0), cB + kstep, voffB); PG8_STAGE(PG8_SA(1, 0), cA + kstep, voffA); PG8_STAGE(PG8_SB(1, 1), cB + hstep + kstep, voffB);
        PG8_WAIT_V(6); PG8_BAR;
    } else {
        PG8_STAGE(PG8_SB(0, 0), cB, voffB); PG8_STAGE(PG8_SA(0, 0), cA, voffA); PG8_STAGE(PG8_SB(0, 1), cB + hstep, voffB); PG8_STAGE(PG8_SA(0, 1), cA + hstep, voffA);
        if (wr == 1) PG8_BAR;
        PG8_WAIT_V(4); PG8_BAR;
        PG8_STAGE(PG8_SB(1, 0), cB + kstep, voffB); PG8_STAGE(PG8_SA(1, 0), cA + kstep, voffA); PG8_STAGE(PG8_SB(1, 1), cB + hstep + kstep, voffB);
        PG8_WAIT_V(6); PG8_BAR;
    }
    for (;;) {
        const bool has_next = S.next(ui + 1, nxt);
        const char* nA = has_next ? (const char*)g.A + (size_t)nxt.pm * tstep : cA; const char* nB = has_next ? (const char*)g.Bt + (size_t)nxt.e * g.bstride + (size_t)nxt.pn * tstep : cB;
        for (int t = 0; t < nt; t += 2) {
            const bool last = (t == nt - 2);
            const char* a1 = cA + (size_t)(t + 1) * kstep;
            const char* a2 = last ? nA : cA + (size_t)(t + 2) * kstep; const char* b2 = last ? nB : cB + (size_t)(t + 2) * kstep;
            const char* a3 = a2 + kstep; const char* b3 = b2 + kstep;
            if (last && has_next) S.a_ready(nxt);
            if constexpr (SP2) {
            PG8_LDB(B0, 0, 0); PG8_LDB(B1, 0, 1); PG8_SCHED; PG8_LDA(At, 0, 0); PG8_STAGE(PG8_SA(1, 1), a1 + hstep, voffA);
            PG8_WAIT_V(8); PG8_WAIT_L(0); PG8_BAR; PG8_MMA(0, 0, At, B0); PG8_MMA(0, 1, At, B1); PG8_BAR; PG8_SCHED;
            PG8_LDA(At, 0, 1); PG8_STAGE(PG8_SB(0, 0), b2, voffB); PG8_STAGE(PG8_SB(0, 1), b2 + hstep, voffB); PG8_STAGE(PG8_SA(0, 0), a2, voffA);
            PG8_WAIT_V(8); PG8_WAIT_L(0); PG8_BAR; PG8_MMA(1, 0, At, B0); PG8_MMA(1, 1, At, B1); PG8_BAR; PG8_SCHED;
            PG8_LDB(B0, 1, 0); PG8_LDB(B1, 1, 1); PG8_SCHED; PG8_LDA(At, 1, 0); PG8_STAGE(PG8_SA(0, 1), a2 + hstep, voffA);
            PG8_WAIT_V(8); PG8_WAIT_L(0); PG8_BAR; PG8_MMA(0, 0, At, B0); PG8_MMA(0, 1, At, B1); PG8_BAR; PG8_SCHED;
            PG8_LDA(At, 1, 1); PG8_STAGE(PG8_SB(1, 0), b3, voffB); PG8_STAGE(PG8_SB(1, 1), b3 + hstep, voffB); PG8_STAGE(PG8_SA(1, 0), a3, voffA);
            PG8_WAIT_V(8); PG8_WAIT_L(0); PG8_BAR; PG8_MMA(1, 0, At, B0); PG8_MMA(1, 1, At, B1); PG8_BAR; PG8_SCHED;
            } else {
            PG8_LDB(B0, 0, 0); PG8_SCHED; PG8_LDA(At, 0, 0); PG8_STAGE(PG8_SA(1, 1), a1 + hstep, voffA);
            PG8_WAIT_L(8); PG8_BAR; PG8_WAIT_L(0); PG8_MMA(0, 0, At, B0); PG8_BAR; PG8_SCHED;
            PG8_LDB(B1, 0, 1); PG8_STAGE(PG8_SB(0, 0), b2, voffB);
            PG8_BAR; PG8_WAIT_L(0); PG8_MMA(0, 1, At, B1); PG8_BAR;
            PG8_LDA(At, 0, 1); PG8_STAGE(PG8_SA(0, 0), a2, voffA);
            PG8_BAR; PG8_WAIT_L(0); PG8_MMA(1, 0, At, B0); PG8_BAR; PG8_SCHED;
            PG8_STAGE(PG8_SB(0, 1), b2 + hstep, voffB);
            PG8_WAIT_V(6); PG8_BAR; PG8_MMA(1, 1, At, B1); PG8_BAR;
            PG8_LDB(B0, 1, 0); PG8_SCHED; PG8_LDA(At, 1, 0); PG8_STAGE(PG8_SA(0, 1), a2 + hstep, voffA);
            PG8_WAIT_L(8); PG8_BAR; PG8_WAIT_L(0); PG8_MMA(0, 0, At, B0); PG8_BAR; PG8_SCHED;
            PG8_LDB(B1, 1, 1); PG8_STAGE(PG8_SB(1, 0), b3, voffB);
            PG8_BAR; PG8_WAIT_L(0); PG8_MMA(0, 1, At, B1); PG8_BAR;
            PG8_LDA(At, 1, 1); PG8_STAGE(PG8_SA(1, 0), a3, voffA);
            PG8_BAR; PG8_WAIT_L(0); PG8_MMA(1, 0, At, B0); PG8_BAR; PG8_SCHED;
            PG8_STAGE(PG8_SB(1, 1), b3 + hstep, voffB);
            PG8_WAIT_V(6); PG8_BAR; PG8_MMA(1, 1, At, B1); PG8_BAR;
            }
        }
        if constexpr (ALIGN_EPI) { if (wr == 0) PG8_BAR; }
        if constexpr (!Epi::AFTER_DRAIN) { E(acc, cur, wr, wc, fr, fq); S.done(cur); }
        if (!has_next) break;
#pragma unroll
        for (int a = 0; a < 2; ++a)
#pragma unroll
            for (int b = 0; b < 2; ++b)
#pragma unroll
                for (int m = 0; m < 4; ++m)
#pragma unroll
                    for (int n = 0; n < 2; ++n) acc[a][b][m][n] = (f32x4){0.f, 0.f, 0.f, 0.f};
        cur = nxt; cA = nA; cB = nB; ++ui;
        if constexpr (ALIGN_EPI) { if (wr == 1) PG8_BAR; }
    }
    PG8_WAIT_V(0);
    if constexpr (!ALIGN_EPI) { if (wr == 0) PG8_BAR; }
    PG8_BAR;
    if constexpr (Epi::AFTER_DRAIN) { E.fused(acc, cur, wr, wc, fr, fq, lds, wid, lane); S.done(cur); }
#undef PG8_SA
#undef PG8_SB
#undef PG8_STAGE
#undef PG8_LDA
#undef PG8_LDB
#undef PG8_MMA
#undef PG8_WAIT_V
#undef PG8_WAIT_L
#undef PG8_BAR
#undef PG8_SCHED
}
}
#define GAS __attribute__((address_space(1)))
#define LAS __attribute__((address_space(3)))
typedef unsigned short bf16;
typedef unsigned v4u __attribute__((ext_vector_type(4)));
typedef float f32x4 __attribute__((ext_vector_type(4)));
typedef short bf16x8 __attribute__((ext_vector_type(8)));
typedef GAS unsigned gu32;
typedef GAS unsigned long long gu64;
#define RLX_AGENT __ATOMIC_RELAXED, __HIP_MEMORY_SCOPE_AGENT
#define LDS_WAIT() asm volatile("s_waitcnt lgkmcnt(0)" ::: "memory")
#define VM_WAIT() asm volatile("s_waitcnt vmcnt(0)" ::: "memory")
__device__ __forceinline__ unsigned long long rt() { return __builtin_amdgcn_s_memrealtime(); }
__device__ __forceinline__ unsigned f2bf(float f) { unsigned u = __builtin_bit_cast(unsigned, f); return (u + 0x7fffu + ((u >> 16) & 1u)) >> 16; }
__device__ __forceinline__ unsigned pk2(float lo, float hi) { return f2bf(lo) | (f2bf(hi) << 16); }
#define XB_TMO      128
#define XB_XCNT(j)  (256  + 64 * (j))
#define XB_XSUB(j)  (1280 + 64 * (j))
#define XB_XGEN(j)  (2304 + 64 * (j))
#define XB_TOP      3328
#define XB_TOPGEN   3392
#define XCD_BAR_WORDS 3456
#define XB_SPIN_CAP (1u << 18)

__device__ __forceinline__ unsigned xb_ld(unsigned* p)              { return __hip_atomic_load(p, __ATOMIC_RELAXED, __HIP_MEMORY_SCOPE_AGENT); }
__device__ __forceinline__ unsigned xb_add(unsigned* p, unsigned v) { return __hip_atomic_fetch_add(p, v, __ATOMIC_RELAXED, __HIP_MEMORY_SCOPE_AGENT); }
__device__ __forceinline__ unsigned xb_xcc_id() { return (unsigned)__builtin_amdgcn_s_getreg((3 << 11) | 20) & 0xFu; }
#define XB_SPIN(cond, bar) do { unsigned _sp = 0; while (cond) { __builtin_amdgcn_s_sleep(1); \
    if ((++_sp & 255u) == 0u) { if (xb_ld(&(bar)[XB_TMO])) break; if (_sp > XB_SPIN_CAP) { atomicAdd(&(bar)[XB_TMO], 1u); break; } } } } while (0)

struct XcdBarrier {
    unsigned* bar; unsigned x;
    volatile LAS unsigned* st;
};

__device__ __forceinline__ XcdBarrier xcd_barrier_post(unsigned* bar, volatile LAS unsigned* st) {
    XcdBarrier b; b.bar = bar; b.x = xb_xcc_id(); b.st = st;
    if (threadIdx.x == 0) (void)xb_add(&bar[XB_XCNT(b.x)], 1u);
    return b;
}
__device__ __forceinline__ void xcd_barrier_complete(unsigned* bar, unsigned x, unsigned& nloc, unsigned& nx) {
    const unsigned G = gridDim.x * gridDim.y * gridDim.z;
    unsigned sum, cnt, mine, sp = 0u;
    for (;;) {
        sum = 0u; cnt = 0u; mine = 0u;
#pragma unroll
        for (unsigned j = 0; j < 16; ++j) { const unsigned c = xb_ld(&bar[XB_XCNT(j)]); sum += c; cnt += (c > 0u) ? 1u : 0u; mine = (j == x) ? c : mine; }
        if (sum == G) break;
        __builtin_amdgcn_s_sleep(1);
        if ((++sp & 255u) == 0u) { if (xb_ld(&bar[XB_TMO])) break; if (sp > XB_SPIN_CAP) { atomicAdd(&bar[XB_TMO], 1u); break; } }
    }
    nloc = mine > 0u ? mine : 1u; nx = cnt > 0u ? cnt : 1u;
}

__device__ __forceinline__ void xcd_barrier(const XcdBarrier& b) {
    asm volatile("s_waitcnt vmcnt(0)" ::: "memory");
    __syncthreads();
    if (threadIdx.x == 0) {
        unsigned* bar = b.bar;
        __builtin_amdgcn_s_waitcnt(0);
        unsigned nloc = b.st[0], nx = b.st[1];
        if (nloc == 0u) { xcd_barrier_complete(bar, b.x, nloc, nx); b.st[0] = nloc; b.st[1] = nx; }
        const unsigned old = xb_add(&bar[XB_XSUB(b.x)], 1u);
        const unsigned gen = old / nloc;
        if (old + 1u == (gen + 1u) * nloc) {
            __builtin_amdgcn_fence(__ATOMIC_RELEASE, "agent");
            asm volatile("s_waitcnt vmcnt(0)" ::: "memory");
            const unsigned og = xb_add(&bar[XB_TOP], 1u);
            const unsigned tg = og / nx;
            if (og + 1u == (tg + 1u) * nx) xb_add(&bar[XB_TOPGEN], 1u);
            else XB_SPIN(xb_ld(&bar[XB_TOPGEN]) == tg, bar);
            __builtin_amdgcn_fence(__ATOMIC_ACQUIRE, "agent");
            xb_add(&bar[XB_XGEN(b.x)], 1u);
            asm volatile("s_waitcnt vmcnt(0)" ::: "memory");
        } else {
            XB_SPIN(xb_ld(&bar[XB_XGEN(b.x)]) == gen, bar);
            __builtin_amdgcn_fence(__ATOMIC_ACQUIRE, "agent");
            asm volatile("s_waitcnt vmcnt(0)" ::: "memory");
        }
    }
    __syncthreads();
}

typedef float f32x16 __attribute__((ext_vector_type(16)));
typedef float f32x2 __attribute__((ext_vector_type(2)));
typedef unsigned u32x2g __attribute__((ext_vector_type(2)));
typedef short v4i16_t __attribute__((ext_vector_type(4)));
enum { IN_X = 0, IN_RELB, IN_LN1G, IN_WIN, IN_LQ1, IN_LK1, IN_LQ2, IN_LK2, IN_SUBLN, IN_CONVW, IN_CONVB, IN_CLNG, IN_CLNB, IN_SLRE, IN_SLIM, IN_SLDT, IN_SBRE, IN_SBIM, IN_SCRE, IN_SCIM,
       IN_SD, IN_GLUW, IN_GLUB, IN_WOUT, IN_LN2G, IN_GRW, IN_GRB, IN_ERW, IN_ERB, IN_WG, IN_WU, IN_WD, IN_FING, N_IN };
struct Args { const float* in[N_IN]; float* out; unsigned char* ws; int ph_lo, ph_hi; };
struct Frame {
    LAS unsigned char* lds; volatile LAS unsigned* MISC; gu32* ctl;
    int tid, lane, wave, vcu, G;
    unsigned char* ws; float* out;
};
__device__ __forceinline__ unsigned pkb(float lo, float hi) { return pg8::pk_bf16(lo, hi); }
__device__ __forceinline__ float bf2f(unsigned short b) { return __builtin_bit_cast(float, (unsigned)b << 16); }
__device__ __forceinline__ float bflo(unsigned w) { return __builtin_bit_cast(float, w << 16); }
__device__ __forceinline__ float bfhi(unsigned w) { return __builtin_bit_cast(float, w & 0xffff0000u); }
__device__ __forceinline__ float wave_sum(float v) {
#pragma unroll
    for (int o = 1; o < 64; o <<= 1) v += __shfl_xor(v, o);
    return v;
}
__device__ __forceinline__ float sigmoidf_(float x) { return __builtin_amdgcn_rcpf(1.0f + __builtin_amdgcn_exp2f(-LOG2E * x)); }
__device__ __forceinline__ float gelu_tanh(float y) {
    const float u2 = 1.5957691216057308f * (y + 0.044715f * y * y * y);
    return y * sigmoidf_(u2);
}

__device__ __forceinline__ void tr_item(const float* W, int K, int N, const float* gain, bf16* WT, int rowbase, LAS float* scr, int k0, int n0, int lane) {
#pragma unroll 8
    for (int i = 0; i < 32; ++i) { const int kk = 2 * i + (lane >> 5); const float g = gain ? gain[k0 + kk] : 1.0f; scr[kk * 33 + (lane & 31)] = W[(size_t)(k0 + kk) * N + n0 + (lane & 31)] * g; }
    LDS_WAIT(); asm volatile("" ::: "memory");
    const int c = lane & 7;
#pragma unroll
    for (int j = 0; j < 4; ++j) { const int n = (lane >> 3) + 8 * j; const LAS float* s = scr + (8 * c) * 33 + n;
        v4u o; o.x = pkb(s[0 * 33], s[1 * 33]); o.y = pkb(s[2 * 33], s[3 * 33]); o.z = pkb(s[4 * 33], s[5 * 33]); o.w = pkb(s[6 * 33], s[7 * 33]);
        *(GAS v4u*)(WT + (size_t)(rowbase + n) * K + k0 + 8 * c) = o; }
    LDS_WAIT(); asm volatile("" ::: "memory");
}
__device__ __forceinline__ void p0_prologue(Frame& F, const Args& A) {
    LAS float* scr = (LAS float*)(F.lds + RING_OFF + F.wave * 16384);
    const int gw = F.vcu * 8 + F.wave, NGW = F.G * 8, lane = F.lane;
    unsigned char* ws = F.ws;
    constexpr int I_SMALL = 1152 + 512 + 32, I_EXP = 768, NITEMS = 2 * I_SMALL + 2 * NE * I_EXP;
    for (int it = gw; it < NITEMS; it += NGW) {
        if (it < 2 * I_SMALL) {
            const int l = it / I_SMALL; int r = it % I_SMALL;
            if (r < 1152) { const int kb = r / 72, nb = r % 72; tr_item(A.in[IN_WIN] + (size_t)l * DM * NCOL, DM, NCOL, A.in[IN_LN1G] + l * DM, (bf16*)(ws + WS_WIN) + (size_t)l * NCOL * DM, 32 * nb, scr, 64 * kb, 32 * nb, lane); continue; }
            r -= 1152;
            if (r < 512) { const int kb = r / 32, nb = r % 32; tr_item(A.in[IN_WOUT] + (size_t)l * DM * DM, DM, DM, nullptr, (bf16*)(ws + WS_WOUT) + (size_t)l * DM * DM, 32 * nb, scr, 64 * kb, 32 * nb, lane); continue; }
            r -= 512;
            { const int kb = r / 8, nb = r % 8; tr_item(A.in[IN_GLUW] + (size_t)l * 256 * 256, 256, 256, nullptr, (bf16*)(ws + WS_WGLU) + (size_t)l * 256 * 256, 32 * nb, scr, 64 * kb, 32 * nb, lane); }
        } else {
            const int r = it - 2 * I_SMALL, le = r / I_EXP, q = r % I_EXP, l = le / NE, mat = q >> 8, idx = q & 255;
            if (mat < 2) { const int kb = idx >> 4, nb = idx & 15, n0 = 32 * nb; const float* W = A.in[mat == 0 ? IN_WG : IN_WU] + (size_t)le * DM * FF;
                tr_item(W, DM, FF, A.in[IN_LN2G] + l * DM, (bf16*)(ws + WS_WGU) + (size_t)le * 1024 * 1024, (n0 >> 7) * 256 + (n0 & 127) + (mat ? 128 : 0), scr, 64 * kb, n0, lane); }
            else { const int kb = idx >> 5, nb = idx & 31; tr_item(A.in[IN_WD] + (size_t)le * FF * DM, FF, DM, nullptr, (bf16*)(ws + WS_WDN) + (size_t)le * DM * FF, 32 * nb, scr, 64 * kb, 32 * nb, lane); }
        }
    }
    const int gt = F.vcu * 512 + F.tid, NGT = F.G * 512;
    for (int i = gt; i < 2 * 64 * 1024; i += NGT) {
        const int l = i >> 16, n = (i >> 10) & 63, k = i & 1023; float v = 0.f; const float g = A.in[IN_LN2G][l * DM + k];
        if (n < 32) v = A.in[IN_ERW][((size_t)l * DM + k) * 32 + n] * g; else if (n < 36) v = A.in[IN_GRW][((size_t)l * DM + k) * 4 + (n - 32)] * g;
        ((bf16*)(ws + WS_WRT))[i] = (bf16)f2bf(v);
    }
    for (int i = gt; i < 2 * 1024; i += NGT) {
        const int l = i >> 10, gp = i & 1023, g = gp >> 6;
        float* P = (float*)(ws + MS_SSMP) + (size_t)l * SP_END;
        const float dt = expf(A.in[IN_SLDT][l * 16 + g]), lr = A.in[IN_SLRE][l * 1024 + gp], li = A.in[IN_SLIM][l * 1024 + gp];
        const float mag = expf(lr * dt), ar = mag * cosf(li * dt), ai = mag * sinf(li * dt), den = lr * lr + li * li;
        const float zr = ((ar - 1.0f) * lr + ai * li) / den, zi = (ai * lr - (ar - 1.0f) * li) / den;
        P[SP_AR + gp] = ar; P[SP_AI + gp] = ai;
        float pr = ar, pi = ai;
#pragma unroll
        for (int s = 0; s < 5; ++s) { const float nr = pr * pr - pi * pi, ni = 2.0f * pr * pi; pr = nr; pi = ni; }
        P[SP_ARL + gp] = pr; P[SP_AIL + gp] = pi;
        for (int h = 0; h < 16; ++h) { const float bre = A.in[IN_SBRE][((size_t)l * 1024 + gp) * 16 + h], bim = A.in[IN_SBIM][((size_t)l * 1024 + gp) * 16 + h];
            P[SP_BBR + gp * 16 + h] = zr * bre - zi * bim; P[SP_BBI + gp * 16 + h] = zr * bim + zi * bre; }
    }
    for (int i = gt; i < 2 * 16 * 16 * 128; i += NGT) {
        const int l = i >> 15, g = (i >> 11) & 15, h = (i >> 7) & 15, pp = i & 127;
        const float v = pp < 64 ? A.in[IN_SCRE][(((size_t)l * 16 + g) * 16 + h) * 64 + pp] : -A.in[IN_SCIM][(((size_t)l * 16 + g) * 16 + h) * 64 + (pp - 64)];
        ((bf16*)(ws + MS_SSMC))[i] = (bf16)f2bf(v);
    }
    for (int i = gt; i < 4 * 132; i += NGT) {
        const int h = i / 132, n = i % 132; int bucket;
        if (n < 16) bucket = n; else if (n >= 128) bucket = 31; else { const float nf = (float)n; int lg = 16 + (int)(logf(nf / 16.0f) / 2.0794415416798357f * 16.0f); bucket = lg < 31 ? lg : 31; }
        ((float*)(ws + MS_LUT))[i] = A.in[IN_RELB][bucket * 4 + h] * LOG2E;
    }
    if (gt < 2) { const int l = gt; float s1 = 0.f, s2 = 0.f;
        for (int d = 0; d < 64; ++d) { s1 += A.in[IN_LQ1][l * 64 + d] * A.in[IN_LK1][l * 64 + d]; s2 += A.in[IN_LQ2][l * 64 + d] * A.in[IN_LK2][l * 64 + d]; }
        const float lam_init = 0.8f - 0.6f * expf(-0.3f * (float)l);
        ((float*)(ws + MS_LAM))[l] = expf(s1) - expf(s2) + lam_init; }
    for (int m = gw; m < NTOK; m += NGW) {
        const GAS f32x4* xr = (const GAS f32x4*)(A.in[IN_X] + (size_t)m * DM) + lane; float s = 0.f;
        GAS unsigned long long* o8 = (GAS unsigned long long*)((bf16*)(ws + WS_XB) + (size_t)m * DM) + lane;
#pragma unroll
        for (int j = 0; j < 4; ++j) { const f32x4 v = xr[64 * j]; s += (v.x * v.x + v.y * v.y) + (v.z * v.z + v.w * v.w);
            o8[64 * j] = (unsigned long long)pkb(v.x, v.y) | ((unsigned long long)pkb(v.z, v.w) << 32); }
        s = wave_sum(s); if (lane == 0) ((float*)(ws + MS_ROWSS))[m] = s;
    }
}

__device__ __forceinline__ void ssm_load_u(Frame& F, int tok0) {
    LAS float* U = (LAS float*)(F.lds);
    const int row = F.tid >> 4, ch = (F.tid & 15) * 16;
    const bf16* src = (const bf16*)(F.ws + WS_PROJ) + (size_t)(tok0 + row) * NCOL + COL_SSM + ch;
    const v4u a = *(const GAS v4u*)src, b = *(const GAS v4u*)(src + 8);
    LAS f32x4* d = (LAS f32x4*)(U + row * 256 + ch);
    d[0] = (f32x4){bflo(a.x), bfhi(a.x), bflo(a.y), bfhi(a.y)}; d[1] = (f32x4){bflo(a.z), bfhi(a.z), bflo(a.w), bfhi(a.w)};
    d[2] = (f32x4){bflo(b.x), bfhi(b.x), bflo(b.y), bfhi(b.y)}; d[3] = (f32x4){bflo(b.z), bfhi(b.z), bflo(b.w), bfhi(b.w)};
}
struct SsmP { float ar, ai; f32x4 br[4], bi[4]; };
__device__ __forceinline__ void ssm_params(SsmP& p, const float* P, int g, int lane) {
    p.ar = P[SP_AR + g * 64 + lane]; p.ai = P[SP_AI + g * 64 + lane];
    const GAS f32x4* b = (const GAS f32x4*)(P + SP_BBR + (g * 64 + lane) * 16); const GAS f32x4* c = (const GAS f32x4*)(P + SP_BBI + (g * 64 + lane) * 16);
#pragma unroll
    for (int i = 0; i < 4; ++i) { p.br[i] = b[i]; p.bi[i] = c[i]; }
}
__device__ __forceinline__ void ssm_step(const SsmP& p, const LAS float* urow, float& sr, float& si) {
    const LAS f32x4* up = (const LAS f32x4*)urow; float bur = 0.f, bui = 0.f;
#pragma unroll
    for (int i = 0; i < 4; ++i) { const f32x4 u = up[i];
        bur += p.br[i].x * u.x; bur += p.br[i].y * u.y; bur += p.br[i].z * u.z; bur += p.br[i].w * u.w;
        bui += p.bi[i].x * u.x; bui += p.bi[i].y * u.y; bui += p.bi[i].z * u.z; bui += p.bi[i].w * u.w; }
    const float nr = p.ar * sr - p.ai * si + bur, ni = p.ar * si + p.ai * sr + bui; sr = nr; si = ni;
}
__device__ __forceinline__ void ssmA_unit(Frame& F, int l, int u) {
    const int b = u >> 8, c = u & 255, tok0 = b * SEQ + c * SSM_LC, lane = F.lane;
    ssm_load_u(F, tok0);
    __syncthreads();
    const float* P = (const float*)(F.ws + MS_SSMP) + (size_t)l * SP_END; const LAS float* U = (const LAS float*)(F.lds);
#pragma unroll 1
    for (int gi = 0; gi < 2; ++gi) { const int g = F.wave * 2 + gi; SsmP p; ssm_params(p, P, g, lane); float sr = 0.f, si = 0.f;
#pragma unroll 4
        for (int t = 0; t < SSM_LC; ++t) ssm_step(p, U + t * 256 + g * 16, sr, si);
        ((GAS f32x2*)(F.ws + WS_SSM))[(((size_t)(b * 256 + c)) * 16 + g) * 64 + lane] = (f32x2){sr, si}; }
    __syncthreads();
}
__device__ __forceinline__ void conv_unit(Frame& F, const Args& A, int l, int u) {
    const int b = u >> 7, t0 = (u & 127) * 64, tid = F.tid, lane = F.lane;
    LAS float* H = (LAS float*)(F.lds);
    const bf16* PR = (const bf16*)(F.ws + WS_PROJ) + (size_t)b * SEQ * NCOL;
#pragma unroll 1
    for (int pass = 0; pass < 6; ++pass) { const int r = pass * 16 + (tid >> 5), c8 = (tid & 31) * 8;
        if (r < 94) { const int t = t0 - 30 + r; f32x4 h0 = {0.f, 0.f, 0.f, 0.f}, h1 = {0.f, 0.f, 0.f, 0.f};
            if (t >= 0) { const bf16* src = PR + (size_t)t * NCOL + COL_CONV + c8; const v4u a = *(const GAS v4u*)src, g = *(const GAS v4u*)(src + 256);
                h0 = (f32x4){bflo(a.x) * sigmoidf_(bflo(g.x)), bfhi(a.x) * sigmoidf_(bfhi(g.x)), bflo(a.y) * sigmoidf_(bflo(g.y)), bfhi(a.y) * sigmoidf_(bfhi(g.y))};
                h1 = (f32x4){bflo(a.z) * sigmoidf_(bflo(g.z)), bfhi(a.z) * sigmoidf_(bfhi(g.z)), bflo(a.w) * sigmoidf_(bflo(g.w)), bfhi(a.w) * sigmoidf_(bfhi(g.w))}; }
            LAS f32x4* d = (LAS f32x4*)(H + r * 256 + c8); d[0] = h0; d[1] = h1; } }
    __syncthreads();
    const int c = tid & 255, half = tid >> 8;
    float w[31];
#pragma unroll
    for (int k = 0; k < 31; ++k) w[k] = A.in[IN_CONVW][((size_t)l * 31 + k) * 256 + c];
    const float bias = A.in[IN_CONVB][l * 256 + c];
    float acc[32];
#pragma unroll
    for (int tb = 0; tb < 4; ++tb) { float hv[38];
#pragma unroll
        for (int i = 0; i < 38; ++i) hv[i] = H[(half * 32 + tb * 8 + i) * 256 + c];
#pragma unroll
        for (int o = 0; o < 8; ++o) { float a = bias;
#pragma unroll
            for (int k = 0; k < 31; ++k) a += w[k] * hv[o + k];
            acc[tb * 8 + o] = a; } }
    __syncthreads();
#pragma unroll
    for (int i = 0; i < 32; ++i) H[(half * 32 + i) * 256 + c] = acc[i];
    __syncthreads();
    const f32x4 lg = *(const GAS f32x4*)(A.in[IN_CLNG] + l * 256 + lane * 4), lb = *(const GAS f32x4*)(A.in[IN_CLNB] + l * 256 + lane * 4);
    bf16* MX = (bf16*)(F.ws + WS_MIX) + ((size_t)b * SEQ + t0) * DM + 512 + lane * 4;
#pragma unroll 2
    for (int i = 0; i < 8; ++i) { const int tk = F.wave * 8 + i; const f32x4 v = *(const LAS f32x4*)(H + tk * 256 + lane * 4);
        const float mean = wave_sum((v.x + v.y) + (v.z + v.w)) * (1.0f / 256.0f); const f32x4 d = v - mean;
        const float var = wave_sum((d.x * d.x + d.y * d.y) + (d.z * d.z + d.w * d.w)) * (1.0f / 256.0f); const float rstd = __builtin_amdgcn_rsqf(var + LN_EPS_C);
        f32x4 y = d * rstd * lg + lb; y = (f32x4){y.x * sigmoidf_(y.x), y.y * sigmoidf_(y.y), y.z * sigmoidf_(y.z), y.w * sigmoidf_(y.w)};
        u32x2g o; o.x = pkb(y.x, y.y); o.y = pkb(y.z, y.w); *(GAS u32x2g*)(MX + (size_t)tk * DM) = o; }
    __syncthreads();
}
constexpr int XS_STRIDE = 136, XS_WAVE = 32 * XS_STRIDE;
constexpr int GT_STRIDE = 264;
constexpr int SSMC_XS_OFF = 32768, SSMC_GT_OFF = SSMC_XS_OFF + 8 * XS_WAVE * 2;
static_assert(SSMC_GT_OFF + 32 * GT_STRIDE * 2 <= RING_BYTES, "SSM-C LDS");
__device__ __forceinline__ void ssmC_unit(Frame& F, const Args& A, int l, int u) {
    const int b = u >> 8, c = u & 255, tok0 = b * SEQ + c * SSM_LC, lane = F.lane, fr = lane & 15, fq = lane >> 4;
    ssm_load_u(F, tok0);
    __syncthreads();
    const float* P = (const float*)(F.ws + MS_SSMP) + (size_t)l * SP_END; const LAS float* U = (const LAS float*)(F.lds);
    LAS bf16* Xs = (LAS bf16*)(F.lds + SSMC_XS_OFF) + F.wave * XS_WAVE; LAS bf16* Gt = (LAS bf16*)(F.lds + SSMC_GT_OFF);
    const bf16* Cm = (const bf16*)(F.ws + MS_SSMC) + (size_t)l * 16 * 16 * 128;
#pragma unroll 1
    for (int gi = 0; gi < 2; ++gi) { const int g = F.wave * 2 + gi; SsmP p; ssm_params(p, P, g, lane);
        const float arL = P[SP_ARL + g * 64 + lane], aiL = P[SP_AIL + g * 64 + lane];
        float xr = 0.f, xi = 0.f;
        { const GAS f32x2* Sp = (const GAS f32x2*)(F.ws + WS_SSM) + (((size_t)b * 256) * 16 + g) * 64 + lane;
#pragma unroll 4
          for (int j = 0; j < c; ++j) { const f32x2 s = Sp[(size_t)j * 1024]; const float nr = arL * xr - aiL * xi + s.x, ni = arL * xi + aiL * xr + s.y; xr = nr; xi = ni; } }
#pragma unroll 4
        for (int t = 0; t < SSM_LC; ++t) { ssm_step(p, U + t * 256 + g * 16, xr, xi); Xs[t * XS_STRIDE + lane] = (bf16)f2bf(xr); Xs[t * XS_STRIDE + 64 + lane] = (bf16)f2bf(xi); }
        LDS_WAIT(); asm volatile("" ::: "memory");
        f32x4 acc[2] = {{0.f, 0.f, 0.f, 0.f}, {0.f, 0.f, 0.f, 0.f}};
#pragma unroll
        for (int s = 0; s < 4; ++s) { const bf16x8 bfr = *(const GAS bf16x8*)(Cm + ((size_t)(g * 16 + fr)) * 128 + 32 * s + 8 * fq);
#pragma unroll
            for (int tb = 0; tb < 2; ++tb) { const bf16x8 afr = *(const LAS bf16x8*)(Xs + (16 * tb + fr) * XS_STRIDE + 32 * s + 8 * fq); acc[tb] = __builtin_amdgcn_mfma_f32_16x16x32_bf16(afr, bfr, acc[tb], 0, 0, 0); } }
        const int ch = g * 16 + fr; const float dv = A.in[IN_SD][l * 256 + ch];
#pragma unroll
        for (int tb = 0; tb < 2; ++tb)
#pragma unroll
            for (int r = 0; r < 4; ++r) { const int t = 16 * tb + 4 * fq + r; const float y = acc[tb][r] + dv * U[t * 256 + ch]; Gt[t * GT_STRIDE + ch] = (bf16)f2bf(gelu_tanh(y)); }
        LDS_WAIT(); asm volatile("" ::: "memory"); }
    __syncthreads();
    const bf16* WG = (const bf16*)(F.ws + WS_WGLU) + (size_t)l * 256 * 256; bf16* MX = (bf16*)(F.ws + WS_MIX) + (size_t)tok0 * DM + 768;
#pragma unroll 1
    for (int nbi = 0; nbi < 2; ++nbi) { const int nb = F.wave * 2 + nbi; f32x4 acc[2] = {{0.f, 0.f, 0.f, 0.f}, {0.f, 0.f, 0.f, 0.f}};
#pragma unroll
        for (int s = 0; s < 8; ++s) { const bf16x8 bfr = *(const GAS bf16x8*)(WG + (size_t)(16 * nb + fr) * 256 + 32 * s + 8 * fq);
#pragma unroll
            for (int tb = 0; tb < 2; ++tb) { const bf16x8 afr = *(const LAS bf16x8*)(Gt + (16 * tb + fr) * GT_STRIDE + 32 * s + 8 * fq); acc[tb] = __builtin_amdgcn_mfma_f32_16x16x32_bf16(afr, bfr, acc[tb], 0, 0, 0); } }
        const int n = 16 * nb + fr; const float gb = A.in[IN_GLUB][l * 256 + n];
#pragma unroll
        for (int tb = 0; tb < 2; ++tb)
#pragma unroll
            for (int r = 0; r < 4; ++r) { const int t = 16 * tb + 4 * fq + r; const float gv = bf2f(Gt[t * GT_STRIDE + n]); MX[(size_t)t * DM + n] = (bf16)f2bf(gv * sigmoidf_(acc[tb][r] + gb)); } }
    __syncthreads();
}

constexpr int AT_STAGE = 32768, AT_EX_OFF = 65536;
constexpr float AT_THR = 8.0f, AT_NEG = -1.0e30f;
__device__ __forceinline__ f32x16 mfma32(bf16x8 a, bf16x8 b, f32x16 c) { return __builtin_amdgcn_mfma_f32_32x32x16_bf16(a, b, c, 0, 0, 0); }
__device__ __forceinline__ void attn_unit(Frame& F, const Args& A, int l, int b, int h, int qi) {
    const int tid = F.tid, lane = F.lane, w = F.wave, r32 = lane & 31, hi = lane >> 5, map = w >> 2, rg = w & 3;
    const bf16* PR = (const bf16*)(F.ws + WS_PROJ) + (size_t)b * SEQ * NCOL;
    const int q0 = qi * 128, qw = q0 + rg * 32, nt = 2 * qi + 2;
    LAS unsigned char* lds = F.lds; LAS float* lut = (LAS float*)(lds + LUT_OFF);
    if (tid < 132) lut[tid] = ((const float*)(F.ws + MS_LUT))[h * 132 + tid];
    bf16x8 qf[4];
    { const bf16* qp = PR + (size_t)(qw + r32) * NCOL + COL_Q + map * 256 + h * 64 + hi * 8;
#pragma unroll
      for (int s = 0; s < 4; ++s) qf[s] = *(const GAS bf16x8*)(qp + 16 * s); }
    const int krow = tid >> 3, kch = tid & 7, vrow = tid >> 4, vch = tid & 15;
    const bf16* kp = PR + (size_t)krow * NCOL + COL_K + h * 64 + kch * 8;
    const bf16* vp = PR + (size_t)vrow * NCOL + COL_V + h * 128 + vch * 8;
    const unsigned kdst = krow * 128 + ((kch ^ ((krow >> 1) & 7)) << 4);
    const unsigned vdst0 = vrow * 256 + ((vch ^ (((vrow & 3) << 2) | ((vrow >> 2) & 3))) << 4);
    const unsigned vdst1 = (vrow + 32) * 256 + ((vch ^ ((((vrow + 32) & 3) << 2) | (((vrow + 32) >> 2) & 3))) << 4);
    v4u sk1, sk2, sv0, sv1;
#define AT_LOAD(j) do { const size_t o_ = (size_t)(j) * 64 * NCOL; sk1 = *(const GAS v4u*)(kp + o_); sk2 = *(const GAS v4u*)(kp + o_ + 256); sv0 = *(const GAS v4u*)(vp + o_); sv1 = *(const GAS v4u*)(vp + o_ + (size_t)32 * NCOL); } while (0)
#define AT_STORE(st) do { LAS unsigned char* s_ = lds + (st) * AT_STAGE; *(LAS v4u*)(s_ + kdst) = sk1; *(LAS v4u*)(s_ + 8192 + kdst) = sk2; *(LAS v4u*)(s_ + 16384 + vdst0) = sv0; *(LAS v4u*)(s_ + 16384 + vdst1) = sv1; } while (0)
    AT_LOAD(0); AT_STORE(0);
    __syncthreads();
    const float c31 = lut[128];
    float m = AT_NEG, lsum = 0.f; f32x16 o[4];
#pragma unroll
    for (int d = 0; d < 4; ++d)
#pragma unroll
        for (int r = 0; r < 16; ++r) o[d][r] = 0.f;
    const unsigned kread = (unsigned)map * 8192u + (unsigned)r32 * 128u;
    const unsigned ksw = (unsigned)((r32 >> 1) & 7);
    const unsigned vq = (unsigned)((lane & 15) >> 2);
    const unsigned vchb = (unsigned)(2 * ((lane >> 4) & 1) + ((lane & 3) >> 1)), vsub = (unsigned)((lane & 1) * 8);
#pragma unroll 1
    for (int j = 0; j < nt; ++j) {
        const bool more = (j + 1 < nt);
        if (more) AT_LOAD(j + 1);
        const bool active = !(j == nt - 1 && rg < 2);
        if (active) {
            LAS unsigned char* st = lds + (j & 1) * AT_STAGE;
            f32x16 p0, p1;
            if (j >= nt - 4) {
                const int relb = (qw + r32) - (64 * j + 4 * hi);
#pragma unroll
                for (int r = 0; r < 16; ++r) { const int rel0 = relb - ((r & 3) + 8 * (r >> 2)), rel1 = rel0 - 32;
                    const int i0 = rel0 < 0 ? 0 : (rel0 > 128 ? 128 : rel0), i1 = rel1 < 0 ? 0 : (rel1 > 128 ? 128 : rel1);
                    const float b0 = lut[i0], b1 = lut[i1]; p0[r] = rel0 < 0 ? AT_NEG : b0; p1[r] = rel1 < 0 ? AT_NEG : b1; }
            } else {
#pragma unroll
                for (int r = 0; r < 16; ++r) { p0[r] = c31; p1[r] = c31; }
            }
#pragma unroll
            for (int s = 0; s < 4; ++s) { const unsigned co = (((unsigned)(2 * s + hi)) ^ ksw) << 4;
                const bf16x8 k0 = *(const LAS bf16x8*)(st + kread + co), k1 = *(const LAS bf16x8*)(st + kread + 4096 + co);
                p0 = mfma32(k0, qf[s], p0); p1 = mfma32(k1, qf[s], p1); }
            float tm = fmaxf(p0[0], p1[0]);
#pragma unroll
            for (int r = 1; r < 16; ++r) tm = fmaxf(tm, fmaxf(p0[r], p1[r]));
            tm = fmaxf(tm, __shfl_xor(tm, 32));
            if (__any(tm > m + AT_THR)) { const float mn = fmaxf(m, tm); const float sc = __builtin_amdgcn_exp2f(m - mn); m = mn; lsum *= sc;
#pragma unroll
                for (int d = 0; d < 4; ++d)
#pragma unroll
                    for (int r = 0; r < 16; ++r) o[d][r] *= sc; }
            float ps = 0.f;
#pragma unroll
            for (int r = 0; r < 16; ++r) { p0[r] = __builtin_amdgcn_exp2f(p0[r] - m); p1[r] = __builtin_amdgcn_exp2f(p1[r] - m); ps += p0[r] + p1[r]; }
            lsum += ps;
            bf16x8 pf[4];
#pragma unroll
            for (int s = 0; s < 4; ++s) { v4u t_;
                if (s < 2) { t_.x = pkb(p0[8 * s + 0], p0[8 * s + 1]); t_.y = pkb(p0[8 * s + 2], p0[8 * s + 3]); t_.z = pkb(p0[8 * s + 4], p0[8 * s + 5]); t_.w = pkb(p0[8 * s + 6], p0[8 * s + 7]); }
                else { const int s2 = s - 2; t_.x = pkb(p1[8 * s2 + 0], p1[8 * s2 + 1]); t_.y = pkb(p1[8 * s2 + 2], p1[8 * s2 + 3]); t_.z = pkb(p1[8 * s2 + 4], p1[8 * s2 + 5]); t_.w = pkb(p1[8 * s2 + 6], p1[8 * s2 + 7]); }
                pf[s] = __builtin_bit_cast(bf16x8, t_); }
            LAS unsigned char* vb = st + 16384;
#pragma unroll
            for (int s = 0; s < 4; ++s) {
                const unsigned rowA = 16u * s + 4u * hi + vq, rowB = rowA + 8u;
                const unsigned swA = ((rowA & 3u) << 2) | ((rowA >> 2) & 3u), swB = ((rowB & 3u) << 2) | ((rowB >> 2) & 3u);
#pragma unroll
                for (int d = 0; d < 4; ++d) { const unsigned ch = 4u * d + vchb;
                    const v4i16_t lo = __builtin_amdgcn_ds_read_tr16_b64_v4i16((LAS v4i16_t*)(vb + rowA * 256u + ((ch ^ swA) << 4) + vsub));
                    const v4i16_t hv = __builtin_amdgcn_ds_read_tr16_b64_v4i16((LAS v4i16_t*)(vb + rowB * 256u + ((ch ^ swB) << 4) + vsub));
                    const bf16x8 vf = (bf16x8){lo[0], lo[1], lo[2], lo[3], hv[0], hv[1], hv[2], hv[3]};
                    o[d] = mfma32(vf, pf[s], o[d]); } }
        }
        if (more) AT_STORE((j + 1) & 1);
        __syncthreads();
    }
#undef AT_LOAD
#undef AT_STORE
    lsum += __shfl_xor(lsum, 32);
    const float inv = 1.0f / lsum;
    LAS float* EX = (LAS float*)(lds + AT_EX_OFF) + rg * 4096;
    if (map == 1) { const float lv = ((const float*)(F.ws + MS_LAM))[l] * inv;
#pragma unroll
        for (int d = 0; d < 4; ++d)
#pragma unroll
            for (int r = 0; r < 16; ++r) EX[(d * 16 + r) * 64 + lane] = o[d][r] * lv; }
    __syncthreads();
    if (map == 0) { float ss = 0.f;
#pragma unroll
        for (int d = 0; d < 4; ++d)
#pragma unroll
            for (int r = 0; r < 16; ++r) { const float v = o[d][r] * inv - EX[(d * 16 + r) * 64 + lane]; o[d][r] = v; ss += v * v; }
        ss += __shfl_xor(ss, 32);
        const float lam_init = 0.8f - 0.6f * __expf(-0.3f * (float)l);
        const float rn = __builtin_amdgcn_rsqf(ss * (1.0f / 128.0f) + RMS_EPS) * (1.0f - lam_init);
        bf16* MX = (bf16*)(F.ws + WS_MIX) + ((size_t)b * SEQ + qw + r32) * DM + h * 128;
        const float* sg = A.in[IN_SUBLN] + l * 128;
#pragma unroll
        for (int d = 0; d < 4; ++d)
#pragma unroll
            for (int g4 = 0; g4 < 4; ++g4) { const int dd = 32 * d + 8 * g4 + 4 * hi; const f32x4 gg = *(const GAS f32x4*)(sg + dd);
                u32x2g ov; ov.x = pkb(o[d][4 * g4 + 0] * rn * gg.x, o[d][4 * g4 + 1] * rn * gg.y); ov.y = pkb(o[d][4 * g4 + 2] * rn * gg.z, o[d][4 * g4 + 3] * rn * gg.w);
                *(GAS u32x2g*)(MX + dd) = ov; } }
}

constexpr int RT_LG_STRIDE = 37;
__device__ __forceinline__ void route_unit(Frame& F, const Args& A, int l, int u) {
    const int lane = F.lane, r32 = lane & 31, hi = lane >> 5, t0 = u * 256 + F.wave * 32;
    LAS float* Lg = (LAS float*)(F.lds) + F.wave * 32 * RT_LG_STRIDE; LAS int* cnt = (LAS int*)(F.lds + 65536);
    if (F.tid < 32) cnt[F.tid] = 0;
    __syncthreads();
    const bf16* xp = (const bf16*)(F.ws + WS_XB) + (size_t)(t0 + r32) * DM + hi * 8; const bf16* wp = (const bf16*)(F.ws + WS_WRT) + (size_t)l * 64 * DM + (size_t)r32 * DM + hi * 8;
    f32x16 a0, a1; float ss = 0.f;
#pragma unroll
    for (int r = 0; r < 16; ++r) { a0[r] = 0.f; a1[r] = 0.f; }
#pragma unroll 4
    for (int s = 0; s < 64; ++s) { const v4u xw = *(const GAS v4u*)(xp + 16 * s); const bf16x8 wa = *(const GAS bf16x8*)(wp + 16 * s), wb = *(const GAS bf16x8*)(wp + 32 * DM + 16 * s);
        const bf16x8 xb = __builtin_bit_cast(bf16x8, xw);
        a0 = mfma32(wa, xb, a0); a1 = mfma32(wb, xb, a1);
        ss += bflo(xw.x) * bflo(xw.x) + bfhi(xw.x) * bfhi(xw.x) + bflo(xw.y) * bflo(xw.y) + bfhi(xw.y) * bfhi(xw.y) + bflo(xw.z) * bflo(xw.z) + bfhi(xw.z) * bfhi(xw.z) + bflo(xw.w) * bflo(xw.w) + bfhi(xw.w) * bfhi(xw.w); }
    ss += __shfl_xor(ss, 32);
    const float rs = __builtin_amdgcn_rsqf(ss * (1.0f / 1024.0f) + RMS_EPS);
#pragma unroll
    for (int r = 0; r < 16; ++r) { const int n = (r & 3) + 8 * (r >> 2) + 4 * hi; Lg[r32 * RT_LG_STRIDE + n] = a0[r] * rs + A.in[IN_ERB][l * 32 + n]; }
    if (hi == 0) {
#pragma unroll
        for (int r = 0; r < 4; ++r) Lg[r32 * RT_LG_STRIDE + 32 + r] = a1[r] * rs + A.in[IN_GRB][l * 4 + r]; }
    LDS_WAIT(); asm volatile("" ::: "memory");
    if (lane < 32) { const LAS float* L = Lg + lane * RT_LG_STRIDE; const int t = t0 + lane;
        int gi = 0; float gm = L[32];
#pragma unroll
        for (int k = 1; k < 4; ++k) { const float v = L[32 + k]; if (v > gm) { gm = v; gi = k; } }
        float gs = 0.f;
#pragma unroll
        for (int k = 0; k < 4; ++k) gs += __expf(L[32 + k] - gm);
        const float gp = 1.0f / gs;
        int i1 = 0; float v1 = L[gi * 8];
#pragma unroll
        for (int k = 1; k < 8; ++k) { const float v = L[gi * 8 + k]; if (v > v1) { v1 = v; i1 = k; } }
        int i2 = -1; float v2 = -3.0e38f;
#pragma unroll
        for (int k = 0; k < 8; ++k) { const float v = L[gi * 8 + k]; if (k != i1 && v > v2) { v2 = v; i2 = k; } }
        const float e2 = __expf(v2 - v1), w1 = 1.0f / (1.0f + e2), w2 = e2 * w1;
        const int e1x = gi * 8 + i1, e2x = gi * 8 + i2;
        ((int*)(F.ws + MS_TOKE))[2 * t] = e1x; ((int*)(F.ws + MS_TOKE))[2 * t + 1] = e2x;
        ((float*)(F.ws + MS_TOKW))[2 * t] = gp * w1; ((float*)(F.ws + MS_TOKW))[2 * t + 1] = gp * w2;
        ((float*)(F.ws + MS_RS2))[t] = rs;
        atomicAdd((int*)&cnt[e1x], 1); atomicAdd((int*)&cnt[e2x], 1); }
    __syncthreads();
    if (F.tid < 32) { const int c = cnt[F.tid]; if (c) atomicAdd((unsigned*)(F.ctl + CW_CNT + l * 32 + F.tid), (unsigned)c); }
    __syncthreads();
}
__device__ __forceinline__ void slots_unit(Frame& F, int l, int u) {
    LAS int* pstart = (LAS int*)(F.lds); LAS int* lcnt = pstart + 32; LAS int* lbase = pstart + 64; LAS int* slots = pstart + 128;
    const int tid = F.tid, lane = F.lane;
    if (tid < 32) lcnt[tid] = 0;
    if (tid == 0) { int acc = 0; for (int e = 0; e < NE; ++e) { const int c = (int)__hip_atomic_load(F.ctl + CW_CNT + l * 32 + e, RLX_AGENT); pstart[e] = acc; acc += ((c + MOEB - 1) / MOEB) * MOEB; }
        if (u == 0) { int nb = 0; for (int e = 0; e < NE; ++e) { const int c = (int)__hip_atomic_load(F.ctl + CW_CNT + l * 32 + e, RLX_AGENT); const int k = (c + MOEB - 1) / MOEB;
                for (int i = 0; i < k; ++i) ((GAS int*)(F.ctl + CW_BLKE + l * NSLOTB))[nb + i] = e; nb += k; }
            *((GAS int*)(F.ctl + CW_NUSED + l)) = nb; } }
    __syncthreads();
    const int t = u * 256 + (tid >> 1), k = tid & 1;
    const int e = ((const int*)(F.ws + MS_TOKE))[2 * t + k];
    const int rank = atomicAdd((int*)&lcnt[e], 1);
    __syncthreads();
    if (tid < 32) { const int c = lcnt[tid]; lbase[tid] = pstart[tid] + (c ? (int)atomicAdd((unsigned*)(F.ctl + CW_CUR + l * 32 + tid), (unsigned)c) : 0); }
    __syncthreads();
    const int slot = lbase[e] + rank;
    slots[tid] = slot;
    ((int*)(F.ws + MS_SLOT))[2 * t + k] = slot;
    ((float*)(F.ws + MS_RSSLOT))[slot] = ((const float*)(F.ws + MS_RS2))[t];
    ((float*)(F.ws + MS_WSLOT))[slot] = ((const float*)(F.ws + MS_TOKW))[2 * t + k];
    __syncthreads();
    bf16* XG = (bf16*)(F.ws + WS_Y);
#pragma unroll 2
    for (int i = 0; i < 32; ++i) { const int tl = F.wave * 32 + i; const int s0 = slots[2 * tl], s1 = slots[2 * tl + 1];
        const GAS v4u* src = (const GAS v4u*)((const bf16*)(F.ws + WS_XB) + (size_t)(u * 256 + tl) * DM) + lane; const v4u a = src[0], b = src[64];
        GAS v4u* d0 = (GAS v4u*)(XG + (size_t)s0 * DM) + lane; GAS v4u* d1 = (GAS v4u*)(XG + (size_t)s1 * DM) + lane;
        d0[0] = a; d0[64] = b; d1[0] = a; d1[64] = b; }
    __syncthreads();
}
__device__ __forceinline__ void combine_rows(Frame& F, const Args& A, bool last) {
    const int gw = F.vcu * 8 + F.wave, NGW = F.G * 8, lane = F.lane;
    const bf16* Y = (const bf16*)(F.ws + WS_Y);
    for (int t = gw; t < NTOK; t += NGW) {
        const int s0 = ((const int*)(F.ws + MS_SLOT))[2 * t], s1 = ((const int*)(F.ws + MS_SLOT))[2 * t + 1];
        GAS f32x4* xr = (GAS f32x4*)(F.out + (size_t)t * DM) + lane;
        const GAS u32x2g* y0 = (const GAS u32x2g*)(Y + (size_t)s0 * DM) + lane; const GAS u32x2g* y1 = (const GAS u32x2g*)(Y + (size_t)s1 * DM) + lane;
        f32x4 v[4]; float s = 0.f;
#pragma unroll
        for (int j = 0; j < 4; ++j) { const f32x4 x = xr[64 * j]; const u32x2g a = y0[64 * j], b = y1[64 * j];
            v[j] = (f32x4){x.x + bflo(a.x) + bflo(b.x), x.y + bfhi(a.x) + bfhi(b.x), x.z + bflo(a.y) + bflo(b.y), x.w + bfhi(a.y) + bfhi(b.y)};
            s += (v[j].x * v[j].x + v[j].y * v[j].y) + (v[j].z * v[j].z + v[j].w * v[j].w); }
        s = wave_sum(s);
        if (!last) { GAS unsigned long long* o8 = (GAS unsigned long long*)((bf16*)(F.ws + WS_XB) + (size_t)t * DM) + lane;
#pragma unroll
            for (int j = 0; j < 4; ++j) { xr[64 * j] = v[j]; o8[64 * j] = (unsigned long long)pkb(v[j].x, v[j].y) | ((unsigned long long)pkb(v[j].z, v[j].w) << 32); }
            if (lane == 0) ((float*)(F.ws + MS_ROWSS))[t] = s;
        } else { const float rs = __builtin_amdgcn_rsqf(s * (1.0f / 1024.0f) + RMS_EPS); const GAS f32x4* fg = (const GAS f32x4*)A.in[IN_FING] + lane;
#pragma unroll
            for (int j = 0; j < 4; ++j) xr[64 * j] = v[j] * rs * fg[64 * j]; }
    }
}

constexpr int PH_PER_LAYER = 9, N_PHASES = 1 + DEPTH * PH_PER_LAYER;
#ifndef MK_ONE_LAUNCH
#define MK_ONE_LAUNCH 1
#endif
__global__ void __launch_bounds__(512, 2) hymba_fwd(Args args) {
    extern __shared__ __attribute__((aligned(16))) unsigned char lds_raw[];
    Frame F;
    F.lds = (LAS unsigned char*)lds_raw;
    F.MISC = (volatile LAS unsigned*)(F.lds + MISC_OFF);
    F.tid = threadIdx.x; F.lane = F.tid & 63; F.wave = __builtin_amdgcn_readfirstlane(F.tid >> 6);
    F.G = gridDim.x; { const int bx = blockIdx.x; F.vcu = (F.G % 8 == 0) ? (bx % 8) * (F.G / 8) + bx / 8 : bx; }
    F.ws = args.ws; F.out = args.out; F.ctl = (gu32*)(args.ws + WS_CTL);
    for (int u = F.tid; u < (LDS_BYTES - LDSCTL_OFF) / 4; u += 512) ((LAS unsigned*)(F.lds + LDSCTL_OFF))[u] = 0u;
    __syncthreads();
    const int lo = args.ph_lo, hi = args.ph_hi;
    const bool fused = (hi - lo) > 1;
    XcdBarrier bar; bar.bar = (unsigned*)(F.ctl + CW_BAR); bar.x = 0; bar.st = nullptr;
    if (fused) bar = xcd_barrier_post((unsigned*)(F.ctl + CW_BAR), F.MISC + 8);
#ifndef ONLY_T
#define ONLY_T -1
#endif
#define PH_EN(t) (ONLY_T < 0 || ONLY_T == (t))
#define IN(k) (lo <= (k) && (k) < hi)
#define REFRESH() do { int t_ = threadIdx.x; asm volatile("" : "+v"(t_)); F.tid = t_; F.lane = t_ & 63; F.wave = __builtin_amdgcn_readfirstlane(t_ >> 6); } while (0)
#define SEAM(k) do { if (IN(k) && IN((k) + 1)) xcd_barrier(bar); } while (0)
    unsigned char* ws = args.ws;
    if (PH_EN(0) && IN(0)) { REFRESH(); p0_prologue(F, args); }
    if (fused && IN(0)) { cg::this_grid().sync(); }
    else SEAM(0);
#pragma unroll 1
    for (int l = 0; l < DEPTH; ++l) {
        const int pb = 1 + l * PH_PER_LAYER;
        if (PH_EN(1) && IN(pb + 0)) {
            pg8::Gemm g{(const pg8::bf16_t*)(ws + WS_XB), (const pg8::bf16_t*)(ws + WS_WIN) + (size_t)l * NCOL * DM, NTOK, NCOL, DM, 0};
            pg8::StaticOrder S; S.init(NTOK, NCOL, F.G, (int)blockIdx.x);
            pg8::EpiProj E{(pg8::bf16_t*)(ws + WS_PROJ), (const float*)(ws + MS_ROWSS)};
            pg8::gemm_phase<pg8::EpiProj, pg8::StaticOrder, true, true>(F.lds + RING_OFF, g, S, E);
        }
        SEAM(pb + 0);
        if (PH_EN(2) && IN(pb + 1)) { REFRESH();
            for (int u = F.vcu; u < NB * SSM_NCH; u += F.G) ssmA_unit(F, l, u);
            for (int u = F.vcu; u < NB * 128; u += F.G) conv_unit(F, args, l, u);
        }
        SEAM(pb + 1);
        if (PH_EN(3) && IN(pb + 2)) { REFRESH();
#ifndef NO_SSMC
            for (int u = F.vcu; u < NB * SSM_NCH; u += F.G) ssmC_unit(F, args, l, u);
#endif
#ifndef NO_ATTN
            if (F.G == 256) { const int bh = F.vcu >> 4, s = F.vcu & 15;
#pragma unroll 1
                for (int i = 0; i < 4; ++i) { const int qi = (i == 0) ? 63 - s : (i == 1) ? 47 - s : (i == 2) ? 16 + s : s; attn_unit(F, args, l, bh >> 2, bh & 3, qi); } }
            else { for (int u = F.vcu; u < 1024; u += F.G) { const int bh = u >> 6, qi = 63 - (u & 63); attn_unit(F, args, l, bh >> 2, bh & 3, qi); } }
#endif
        }
        SEAM(pb + 2);
        if (PH_EN(4) && IN(pb + 3)) {
            pg8::Gemm g{(const pg8::bf16_t*)(ws + WS_MIX), (const pg8::bf16_t*)(ws + WS_WOUT) + (size_t)l * DM * DM, NTOK, DM, DM, 0};
            pg8::StaticOrder S; S.init(NTOK, DM, F.G, (int)blockIdx.x);
            pg8::EpiResid E{l == 0 ? args.in[IN_X] : (const float*)args.out, args.out, (pg8::bf16_t*)(ws + WS_XB)};
            pg8::gemm_phase<pg8::EpiResid, pg8::StaticOrder, true, true>(F.lds + RING_OFF, g, S, E);
        }
        SEAM(pb + 3);
        if (PH_EN(5) && IN(pb + 4)) { REFRESH(); for (int u = F.vcu; u < NTOK / 256; u += F.G) route_unit(F, args, l, u); }
        SEAM(pb + 4);
        if (PH_EN(6) && IN(pb + 5)) { REFRESH(); for (int u = F.vcu; u < NTOK / 256; u += F.G) slots_unit(F, l, u); }
        SEAM(pb + 5);
        if (PH_EN(7) && IN(pb + 6)) {
            const int n_used = (int)__hip_atomic_load(F.ctl + CW_NUSED + l, RLX_AGENT);
            pg8::Gemm g{(const pg8::bf16_t*)(ws + WS_Y), (const pg8::bf16_t*)(ws + WS_WGU) + (size_t)l * NE * 1024 * 1024, PSLOTS, 1024, DM, (size_t)1024 * 1024 * 2};
            pg8::GroupedOrder S; S.init(n_used, 4, F.G, (int)blockIdx.x, (const int*)(F.ctl + CW_BLKE + l * NSLOTB));
            pg8::EpiGateUp E{(pg8::bf16_t*)(ws + WS_ACT), (const float*)(ws + MS_RSSLOT)};
            pg8::gemm_phase<pg8::EpiGateUp, pg8::GroupedOrder, true, true>(F.lds + RING_OFF, g, S, E);
        }
        SEAM(pb + 6);
        if (PH_EN(8) && IN(pb + 7)) {
            const int n_used = (int)__hip_atomic_load(F.ctl + CW_NUSED + l, RLX_AGENT);
            pg8::Gemm g{(const pg8::bf16_t*)(ws + WS_ACT), (const pg8::bf16_t*)(ws + WS_WDN) + (size_t)l * NE * DM * FF, PSLOTS, DM, FF, (size_t)DM * FF * 2};
            pg8::GroupedOrder S; S.init(n_used, 4, F.G, (int)blockIdx.x, (const int*)(F.ctl + CW_BLKE + l * NSLOTB));
            pg8::EpiDown E{(pg8::bf16_t*)(ws + WS_Y), (const float*)(ws + MS_WSLOT)};
            pg8::gemm_phase<pg8::EpiDown, pg8::GroupedOrder, true, true>(F.lds + RING_OFF, g, S, E);
        }
        SEAM(pb + 7);
        if (PH_EN(9) && IN(pb + 8)) { REFRESH(); combine_rows(F, args, l == DEPTH - 1); }
        SEAM(pb + 8);
    }
#undef IN
#undef SEAM
}

extern "C" void kernel_launch(void* const* d_in, const int* in_sizes, int n_in, void* d_out, int out_size, void* d_ws, size_t ws_size, hipStream_t stream) {
    static int grid = 0;
    if (grid == 0) {
        if (n_in != N_IN || in_sizes[0] != NTOK * DM || out_size != NTOK * DM || ws_size < WS_END) { fprintf(stderr, "kernel_launch: unexpected shapes (n_in %d, in0 %d, out %d, ws %zu)\n", n_in, n_in > 0 ? in_sizes[0] : -1, out_size, ws_size); grid = -1; return; }
        int dev = 0, cus = 0, per_cu = 0;
        if (hipGetDevice(&dev) != hipSuccess || hipDeviceGetAttribute(&cus, hipDeviceAttributeMultiprocessorCount, dev) != hipSuccess) { grid = -1; return; }
        if (hipFuncSetAttribute((const void*)hymba_fwd, hipFuncAttributeMaxDynamicSharedMemorySize, LDS_BYTES) != hipSuccess) { fprintf(stderr, "kernel_launch: hipFuncSetAttribute failed\n"); grid = -1; return; }
        if (hipOccupancyMaxActiveBlocksPerMultiprocessor(&per_cu, (const void*)hymba_fwd, 512, LDS_BYTES) != hipSuccess || per_cu < 1) { fprintf(stderr, "kernel_launch: occupancy query says %d blocks per CU\n", per_cu); (void)hipGetLastError(); grid = -1; return; }
        grid = cus;
    }
    if (grid < 0) return;
    (void)hipMemsetAsync((char*)d_ws + WS_CTL, 0, CTL_ZERO_BYTES, stream);
    Args a{};
    for (int i = 0; i < N_IN; ++i) a.in[i] = (const float*)d_in[i];
    a.out = (float*)d_out; a.ws = (unsigned char*)d_ws;
#if MK_ONE_LAUNCH
    a.ph_lo = 0; a.ph_hi = N_PHASES;
    void* kargs[] = {&a};
    hipError_t e = hipLaunchCooperativeKernel((const void*)hymba_fwd, dim3(grid), dim3(512), kargs, LDS_BYTES, stream);
    if (e != hipSuccess) fprintf(stderr, "kernel_launch: cooperative launch failed: %s (grid %d)\n", hipGetErrorString(e), grid);
#else
    for (int p = 0; p < N_PHASES; ++p) { a.ph_lo = p; a.ph_hi = p + 1; hipLaunchKernelGGL(hymba_fwd, dim3(grid), dim3(512), LDS_BYTES, stream, a); }
#endif
}
```

```cpp
#include <hip/hip_runtime.h>
#include <hip/hip_cooperative_groups.h>
#include <cstdio>
#include <cstdint>
namespace cg = cooperative_groups;
#define MK_ONE_LAUNCH 1
#define DUP_T -1
#define AT_STAGGER 0
#define AT_PIPE 0

constexpr int DM = 1024, NB = 4, SEQ = 8192, NTOK = NB * SEQ, DEPTH = 2;
constexpr int NCOL = 2304;
constexpr int NCOLP = 1280;
constexpr int COL_Q = 0, COL_CONV = 512, COL_SSM = 1024;
constexpr int NE = 32, FF = 512, MOEB = 256, NSLOTB = 288, PSLOTS = NSLOTB * MOEB;
constexpr int SSM_RUN = 128, SSM_NRUN = SEQ / SSM_RUN;
constexpr float RMS_EPS = 1e-6f, LN_EPS_C = 1e-5f;
constexpr float LOG2E = 1.4426950408889634f;
constexpr float QSCALE = 0.125f * LOG2E;

constexpr size_t MiB = 1u << 20;
constexpr size_t WS_CTL = 0, CTL_ZERO_BYTES = 1 * MiB;
constexpr size_t WS_WIN = 2 * MiB;
constexpr size_t WS_WOUT = 11 * MiB;
constexpr size_t WS_WGLU = 15 * MiB;
constexpr size_t WS_WRT = 16 * MiB;
constexpr size_t WS_WGU = 17 * MiB;
constexpr size_t WS_WDN = 145 * MiB;
constexpr size_t WS_XB = 209 * MiB;
constexpr size_t WS_PROJ = 273 * MiB;
constexpr size_t WS_KVH = WS_PROJ + 80 * MiB;
constexpr size_t WS_MIX = 417 * MiB;
constexpr size_t WS_SSM = 481 * MiB;
constexpr size_t WS_ACT = WS_PROJ;
constexpr size_t WS_Y = WS_PROJ + 72 * MiB;
constexpr size_t WS_MISC = 489 * MiB;
constexpr size_t MS_ROWSS = WS_MISC;
constexpr size_t MS_TOKE = MS_ROWSS + 128 * 1024;
constexpr size_t MS_TOKW = MS_TOKE + 256 * 1024;
constexpr size_t MS_RS2 = MS_TOKW + 256 * 1024;
constexpr size_t MS_SLOT = MS_RS2 + 128 * 1024;
constexpr size_t MS_RSSLOT = MS_SLOT + 256 * 1024;
constexpr size_t MS_WSLOT = MS_RSSLOT + 288 * 1024;
constexpr size_t MS_TOKSLOT = MS_WSLOT + 288 * 1024;
constexpr size_t MS_SSMP = MS_TOKSLOT + 288 * 1024;
constexpr int SP_AR = 0, SP_AI = 1024, SP_ARL = 2048, SP_AIL = 3072, SP_BBR = 4096, SP_BBI = 4096 + 16384, SP_END = 4096 + 32768;
constexpr size_t MS_SSMC = MS_SSMP + 2 * SP_END * 4;
constexpr size_t MS_LUT = MS_SSMC + 2 * 16 * 16 * 128 * 2;
constexpr size_t MS_LAM = MS_LUT + 4 * 132 * 4;
constexpr size_t WS_END = 497 * MiB;
static_assert(MS_LAM + 64 <= WS_END, "misc region");
constexpr int CW_BAR = 4096;
constexpr int CW_CNT = 16384;
constexpr int CW_CUR = 16384 + 64;
constexpr int CW_NUSED = 16384 + 128;
constexpr int CW_BLKE = 16384 + 256;
constexpr int CW_GUD = 16384 + 2048;
constexpr int CW_XCC = CW_GUD + 3 * 4096;
constexpr int CW_RT = CW_XCC + 256;

constexpr int RING_OFF = 0, RING_BYTES = 131072;
constexpr int LDSCTL_OFF = RING_BYTES, MISC_OFF = LDSCTL_OFF + 320;
constexpr int LUT_OFF = MISC_OFF + 128;
constexpr int SCAL_OFF = LUT_OFF + 4096;
constexpr int LDS_BYTES = 147456;
static_assert(LUT_OFF + 384 * 4 <= SCAL_OFF && SCAL_OFF % 16 == 0 && SCAL_OFF + 1024 <= LDS_BYTES, "LDS map");
namespace pg8 {
#define PG8_LAS __attribute__((address_space(3)))
typedef unsigned short bf16_t;
typedef short bf16x8 __attribute__((ext_vector_type(8)));
typedef float f32x4 __attribute__((ext_vector_type(4)));
typedef unsigned u32x4 __attribute__((ext_vector_type(4)));
constexpr int BM = 256, BK = 64, HALF = 128, HTB = HALF * BK * 2  , STAGE_BYTES = 8 * HTB, NXCD = 8, WGM = 8;

__host__ __device__ __forceinline__ int lds_byte(int r, int c) { const int st = (r >> 4) * 2 + (c >> 5), rr = r & 15, cc = c & 31, ob = rr * 64 + cc * 2; return st * 1024 + (ob ^ (((ob >> 9) & 1) << 5)); }
__host__ __device__ __forceinline__ void stage_rc(int b, int& R, int& C) { const int st = b / 1024, sb = b % 1024, swz = sb ^ (((sb >> 9) & 1) << 5); R = (st >> 1) * 16 + swz / 64; C = (st & 1) * 32 + (swz % 64) / 2; }
__host__ __device__ __forceinline__ int perm32(int rho) { const int n = rho >> 4, i = rho & 15; return 8 * (i >> 2) + 4 * n + (i & 3); }

struct Unit { int pm, pn, e; };
struct Gemm { const bf16_t* A; const bf16_t* Bt; int M, N, K; size_t bstride; const int* gat; const float* scal; unsigned scal_lds; };

struct StaticOrder {
    int nM, nN, nwg, G, c;
    __host__ __device__ void init(int M, int N, int G_, int c_) { nM = M / BM; nN = N / BM; nwg = nM * nN; G = G_; c = c_; }
    __host__ __device__ bool next(int i, Unit& u) const {
        const long L = (long)i * G + c; if (L >= nwg) return false;
        int wgid = (int)L; { const int q = nwg / NXCD, r = nwg % NXCD, xcd = wgid % NXCD, off = wgid / NXCD; wgid = (xcd < r ? xcd * (q + 1) : r * (q + 1) + (xcd - r) * q) + off; }
        const int nig = WGM * nN, gid = wgid / nig, fm = gid * WGM, gsz = (nM - fm) < WGM ? (nM - fm) : WGM;
        u.pm = fm + ((wgid % nig) % gsz); u.pn = (wgid % nig) / gsz; u.e = 0; return true;
    }
    __device__ __forceinline__ void a_ready(const Unit&) const {}
    __device__ __forceinline__ void done(const Unit&) const {}
};


typedef float f32x2e __attribute__((ext_vector_type(2))); typedef __bf16 bf16x2e __attribute__((ext_vector_type(2))); typedef unsigned u32x2 __attribute__((ext_vector_type(2)));
__device__ __forceinline__ unsigned pk_bf16(float lo, float hi) { f32x2e v = {lo, hi}; bf16x2e b = __builtin_convertvector(v, bf16x2e); return __builtin_bit_cast(unsigned, b); }
__device__ __forceinline__ u32x4 pk8(const f32x4& v0, const f32x4& v1) { u32x4 w; w.x = pk_bf16(v0[0], v0[1]); w.y = pk_bf16(v0[2], v0[3]); w.z = pk_bf16(v1[0], v1[1]); w.w = pk_bf16(v1[2], v1[3]); return w; }

struct EpiProj {
    static constexpr bool PERM = true, AFTER_DRAIN = false;
    bf16_t* O; bf16_t* KVH; const PG8_LAS float* sl;
    __device__ __forceinline__ void operator()(const f32x4 (&acc)[2][2][4][2], const Unit& u, int wr, int wc, int fr, int fq) const {
        const int row0 = u.pm * BM + wr * 64 + fr, cw = wc * 32 + 8 * fq;
        const int pn = u.pn; const float cs = (pn < 2) ? QSCALE : 1.0f;
        const int pcol = (pn < 2) ? pn * 256 : (pn == 6 ? 1024 : (pn - 7) * 256 + 512);
#pragma unroll
        for (int ai = 0; ai < 2; ++ai)
#pragma unroll
            for (int m = 0; m < 4; ++m) { const int row = row0 + ai * HALF + m * 16; const float rs = __builtin_amdgcn_rsqf(sl[row - u.pm * BM] * (1.0f / 1024.0f) + RMS_EPS) * cs;
                const int bb = row >> 13, tl = row & 8191, jt = tl >> 6, kr = tl & 63;
#pragma unroll
                for (int bj = 0; bj < 2; ++bj) { const f32x4 v0 = acc[ai][bj][m][0] * rs, v1 = acc[ai][bj][m][1] * rs; const u32x4 w = pk8(v0, v1); const int c = cw + bj * HALF;
                    if (pn < 2 || pn >= 6) { *(u32x4*)(O + (size_t)row * NCOLP + pcol + c) = w; }
                    else if (pn < 4) { const int hh = c >> 6, ch = (c & 63) >> 3;
                        char* img = (char*)KVH + ((size_t)((bb * 4 + hh) * 128 + jt) << 15) + (pn - 2) * 8192;
                        *(u32x4*)(img + kr * 128 + ((ch ^ ((kr >> 1) & 7)) << 4)) = w; }
                    else { const int c5 = (pn - 4) * 256 + c, hh = c5 >> 7, ch = (c5 & 127) >> 3;
                        char* img = (char*)KVH + ((size_t)((bb * 4 + hh) * 128 + jt) << 15) + 16384;
                        *(u32x4*)(img + kr * 256 + ((ch ^ (((kr & 3) << 2) | ((kr >> 2) & 3))) << 4)) = w; } } }
    }
};
struct EpiResid {
    static constexpr bool PERM = true, AFTER_DRAIN = false;
    bf16_t* XB; bf16_t* XO;
    __device__ __forceinline__ void operator()(const f32x4 (&acc)[2][2][4][2], const Unit& u, int wr, int wc, int fr, int fq) const {
        const int row0 = u.pm * BM + wr * 64 + fr, col0 = u.pn * BM + wc * 32 + 8 * fq;
#pragma unroll
        for (int ai = 0; ai < 2; ++ai)
#pragma unroll
            for (int m = 0; m < 4; ++m) { const size_t ro = (size_t)(row0 + ai * HALF + m * 16) * DM + col0; const bf16_t* rowp = XB + ro; bf16_t* rowo = XO + ro;
#pragma unroll
                for (int bj = 0; bj < 2; ++bj) { const u32x4 x = *(const u32x4*)(rowp + bj * HALF); f32x4 v0 = acc[ai][bj][m][0], v1 = acc[ai][bj][m][1];
                    v0[0] += __builtin_bit_cast(float, x.x << 16); v0[1] += __builtin_bit_cast(float, x.x & 0xffff0000u); v0[2] += __builtin_bit_cast(float, x.y << 16); v0[3] += __builtin_bit_cast(float, x.y & 0xffff0000u);
                    v1[0] += __builtin_bit_cast(float, x.z << 16); v1[1] += __builtin_bit_cast(float, x.z & 0xffff0000u); v1[2] += __builtin_bit_cast(float, x.w << 16); v1[3] += __builtin_bit_cast(float, x.w & 0xffff0000u);
                    *(u32x4*)(rowo + bj * HALF) = pk8(v0, v1); } }
    }
};
struct EpiGateUp {
    static constexpr bool PERM = true, AFTER_DRAIN = false;
    bf16_t* ACT; const PG8_LAS float* sl;
    __device__ __forceinline__ void operator()(const f32x4 (&acc)[2][2][4][2], const Unit& u, int wr, int wc, int fr, int fq) const {
        const int row0 = u.pm * BM + wr * 64 + fr, col0 = u.pn * HALF + wc * 32 + 8 * fq;
#pragma unroll
        for (int ai = 0; ai < 2; ++ai)
#pragma unroll
            for (int m = 0; m < 4; ++m) { const int row = row0 + ai * HALF + m * 16; const float rs = sl[row - u.pm * BM]; f32x4 a[2];
#pragma unroll
                for (int n = 0; n < 2; ++n) { const f32x4 g = acc[ai][0][m][n] * rs, up = acc[ai][1][m][n] * rs;
#pragma unroll
                    for (int j = 0; j < 4; ++j) a[n][j] = g[j] * __builtin_amdgcn_rcpf(1.0f + __builtin_amdgcn_exp2f(-LOG2E * g[j])) * up[j]; }
                *(u32x4*)(ACT + (size_t)row * FF + col0) = pk8(a[0], a[1]); }
    }
};
struct EpiDown {
    static constexpr bool PERM = true, AFTER_DRAIN = false;
    bf16_t* Y; const PG8_LAS float* sl;
    __device__ __forceinline__ void operator()(const f32x4 (&acc)[2][2][4][2], const Unit& u, int wr, int wc, int fr, int fq) const {
        const int row0 = u.pm * BM + wr * 64 + fr, col0 = u.pn * BM + wc * 32 + 8 * fq;
#pragma unroll
        for (int ai = 0; ai < 2; ++ai)
#pragma unroll
            for (int m = 0; m < 4; ++m) { const int row = row0 + ai * HALF + m * 16; const float ws = sl[row - u.pm * BM]; bf16_t* rowp = Y + (size_t)row * DM + col0;
#pragma unroll
                for (int bj = 0; bj < 2; ++bj) { const f32x4 v0 = acc[ai][bj][m][0] * ws, v1 = acc[ai][bj][m][1] * ws; *(u32x4*)(rowp + bj * HALF) = pk8(v0, v1); } }
    }
};
struct GroupedOrder {
    int nwg, nN, G, c; const int* blk_e;
    __device__ void init(int n_used, int nN_, int G_, int c_, const int* be) { nN = nN_; nwg = n_used * nN_; G = G_; c = c_; blk_e = be; }
    __device__ bool next(int i, Unit& u) const { const long L = (long)i * G + c; const int grp = (int)(L >> 5), w = (int)(L & 31); const int pm = grp * 8 + (w >> 2); if (pm * nN >= nwg) return false; u.pm = pm; u.pn = w & 3; u.e = blk_e[pm]; return true; }
    __device__ __forceinline__ void a_ready(const Unit&) const {}
    __device__ __forceinline__ void done(const Unit&) const {}
};
#define PG8_GAS __attribute__((address_space(1)))
struct DownOrder {
    int nwg, G, c, r, nB, base, own, y, partA, gmax; const int* blk_e; const PG8_GAS unsigned* qd; const PG8_GAS unsigned* xtab; mutable int seen_own; mutable unsigned relmask;
    __device__ void init(int n_used, int G_, int c_, const int* be, const PG8_GAS unsigned* qd_, const PG8_GAS unsigned* xtab_) { nwg = n_used * 4; G = G_; c = c_; r = nwg % G_; nB = G_ - r; base = nwg / G_; blk_e = be; qd = qd_; xtab = xtab_; seen_own = 1; relmask = 0u;
        int rem = nwg, yA = 0, yB = 0, pA = 0, pB = 0;
        for (int k = 0; rem > 0 && k < 4096; ++k) { const bool isB = (k < 2) || (k & 1); const int cap = isB ? nB : r; if (cap == 0) continue;
            if (rem >= cap) { if (isB) ++yB; else ++yA; rem -= cap; } else { if (isB) pB = rem; else pA = rem; rem = 0; } }
        const bool isA = c_ < r; own = base + (isA ? 1 : 0); y = isA ? yA + (c_ < pA ? 1 : 0) : yB + ((c_ - r) < pB ? 1 : 0); partA = pA; gmax = base + 1 - yA;
#ifndef MOE_DEAL
#define MOE_DEAL 1
#endif
        if (MOE_DEAL == 0) y = own;
        if (yA > base + 1 || yB < base) { y = own; }
    }
    __device__ bool next(int i, Unit& u) const {
        if (i >= y) return false;
        long L;
        if (i < own) L = (long)i * G + c;
        else { const int s = (i - own) * nB + (c - r); int k, cg;
            if (s < (gmax - 1) * r) { k = s / r; cg = s - k * r; } else { k = gmax - 1; cg = s - (gmax - 1) * r + partA; }
            L = (long)(base - k) * G + cg; }
        u.pm = (int)(L >> 2); u.pn = (int)(L & 3); u.e = blk_e[u.pm]; return true; }
    __device__ __forceinline__ static void poll_ge(const PG8_GAS unsigned* p, unsigned want) {
        for (unsigned spins = 0; spins < (1u << 22); ++spins) { if ((unsigned)__builtin_amdgcn_readfirstlane((int)__hip_atomic_load(p, __ATOMIC_RELAXED, __HIP_MEMORY_SCOPE_AGENT)) >= want) break; __builtin_amdgcn_s_sleep(2); } }
    __device__ __forceinline__ void a_ready(const Unit& u) const {
        const int q = ((u.pm * 4 + u.pn) % G) >> 2;
        if (q == (c >> 2)) { if (seen_own) return; poll_ge(qd + q * 64, 4u); seen_own = 1; __builtin_amdgcn_fence(__ATOMIC_ACQUIRE, "agent"); asm volatile("s_waitcnt vmcnt(0)" ::: "memory"); }
        else { for (int k = 0; k < 4; ++k) { const unsigned x = ((unsigned)__builtin_amdgcn_readfirstlane((int)__hip_atomic_load(xtab + q * 4 + k, __ATOMIC_RELAXED, __HIP_MEMORY_SCOPE_AGENT)) - 1u) & 15u;
                if (!((relmask >> x) & 1u)) { poll_ge(qd + x * 64 + 17, 1u); relmask |= 1u << x; } } }
    }
    __device__ __forceinline__ void done(const Unit&) const {}
};
template <class Epi, class Sched, bool ALIGN_EPI = false, bool SP2 = false, bool GATHER = false>
__device__ __forceinline__ void gemm_phase(PG8_LAS unsigned char* lds, const Gemm g, const Sched& S, const Epi& E) {
    int tid_ = threadIdx.x; asm volatile("" : "+v"(tid_));
    const int tid = tid_, wid = __builtin_amdgcn_readfirstlane(tid >> 6), lane = tid & 63, wr = wid >> 2, wc = wid & 3, fr = lane & 15, fq = lane >> 4;
    const int K = g.K, nt = K / BK;
    unsigned voffA[2], voffB[2];
#pragma unroll
    for (int i = 0; i < 2; ++i) { int R, C; stage_rc(tid * 16 + i * 8192, R, C); const int Rb = Epi::PERM ? ((R & ~31) + perm32(R & 31)) : R;
        voffA[i] = (unsigned)(R * K + C) * 2u; voffB[i] = (unsigned)(Rb * K + C) * 2u; }
    int gR[2], gC2[2];
#pragma unroll
    for (int i = 0; i < 2; ++i) { int R, C; stage_rc(tid * 16 + i * 8192, R, C); gR[i] = R; gC2[i] = C * 2; }
    unsigned vA[2][2], vN[2][2];
#define PG8_GOFF(dst, pm_) do { _Pragma("unroll") for (int h_ = 0; h_ < 2; ++h_) _Pragma("unroll") for (int i_ = 0; i_ < 2; ++i_) \
        dst[h_][i_] = (unsigned)g.gat[(pm_) * BM + h_ * HALF + gR[i_]] * (unsigned)(K * 2) + (unsigned)gC2[i_]; } while (0)
    const size_t kstep = (size_t)(BK * 2);
    const size_t hstep = (size_t)HALF * K * 2;
    const size_t tstep = 2 * hstep;
    const unsigned ldsw = (unsigned)wid * 1024u;
    const int aoff = lds_byte(wr * 64 + fr, fq * 8), boff = lds_byte(wc * 32 + fr, fq * 8);
#define PG8_SA(b, h) (((b) * 2 + (h)) * HTB)
#define PG8_SB(b, h) ((4 + (b) * 2 + (h)) * HTB)
#define PG8_STAGE(bufoff, gbase, voff) do { _Pragma("unroll") for (int _i = 0; _i < 2; ++_i) \
        __builtin_amdgcn_global_load_lds((const unsigned*)((const char*)(gbase) + (voff)[_i]), (PG8_LAS unsigned*)(lds + (bufoff) + ldsw + _i * 8192), 16, 0, 0); } while (0)
#define PG8_STAGEA(b, h, ptr, isn) do { if constexpr (GATHER) { unsigned vs_[2]; vs_[0] = (isn) ? vN[h][0] : vA[h][0]; vs_[1] = (isn) ? vN[h][1] : vA[h][1]; PG8_STAGE(PG8_SA(b, h), ptr, vs_); } \
        else { PG8_STAGE(PG8_SA(b, h), (ptr) + (h) * hstep, voffA); } } while (0)
#define PG8_LDA(dst, b, h) do { _Pragma("unroll") for (int m = 0; m < 4; ++m) _Pragma("unroll") for (int k = 0; k < 2; ++k) dst[m][k] = *(const PG8_LAS bf16x8*)(lds + PG8_SA(b, h) + aoff + m * 2048 + k * 1024); } while (0)
#define PG8_LDB(dst, b, h) do { _Pragma("unroll") for (int n = 0; n < 2; ++n) _Pragma("unroll") for (int k = 0; k < 2; ++k) dst[n][k] = *(const PG8_LAS bf16x8*)(lds + PG8_SB(b, h) + boff + n * 2048 + k * 1024); } while (0)
#define PG8_MMA(ai, bj, At, Bt) do { __builtin_amdgcn_s_setprio(1); _Pragma("unroll") for (int m = 0; m < 4; ++m) _Pragma("unroll") for (int n = 0; n < 2; ++n) _Pragma("unroll") for (int k = 0; k < 2; ++k) \
        acc[ai][bj][m][n] = __builtin_amdgcn_mfma_f32_16x16x32_bf16(Bt[n][k], At[m][k], acc[ai][bj][m][n], 0, 0, 0); __builtin_amdgcn_s_setprio(0); } while (0)
#define PG8_WAIT_V(n) asm volatile("s_waitcnt vmcnt(" #n ")" ::: "memory")
#define PG8_WAIT_L(n) asm volatile("s_waitcnt lgkmcnt(" #n ")" ::: "memory")
#define PG8_BAR __builtin_amdgcn_s_barrier()
#define PG8_SCHED __builtin_amdgcn_sched_barrier(0)
    Unit cur, nxt; int ui = 0;
    if (!S.next(0, cur)) return;
    f32x4 acc[2][2][4][2];
#pragma unroll
    for (int a = 0; a < 2; ++a)
#pragma unroll
        for (int b = 0; b < 2; ++b)
#pragma unroll
            for (int m = 0; m < 4; ++m)
#pragma unroll
                for (int n = 0; n < 2; ++n) acc[a][b][m][n] = (f32x4){0.f, 0.f, 0.f, 0.f};
    bf16x8 At[4][2], B0[2][2], B1[2][2];
    const char* cA = (const char*)g.A + (GATHER ? (size_t)0 : (size_t)cur.pm * tstep); if constexpr (GATHER) { PG8_GOFF(vA, cur.pm); } const char* cB = (const char*)g.Bt + (size_t)cur.e * g.bstride + (size_t)cur.pn * tstep;
    S.a_ready(cur);
    if constexpr (SP2) {
        PG8_STAGE(PG8_SB(0, 0), cB, voffB); PG8_STAGE(PG8_SB(0, 1), cB + hstep, voffB); PG8_STAGEA(0, 0, cA, false); PG8_STAGEA(0, 1, cA, false);
        if (wr == 1) PG8_BAR;
        PG8_WAIT_V(2); PG8_BAR;
        PG8_STAGE(PG8_SB(1, 0), cB + kstep, voffB); PG8_STAGEA(1, 0, cA + kstep, false); PG8_STAGE(PG8_SB(1, 1), cB + hstep + kstep, voffB);
        PG8_WAIT_V(6); PG8_BAR;
    } else {
        PG8_STAGE(PG8_SB(0, 0), cB, voffB); PG8_STAGEA(0, 0, cA, false); PG8_STAGE(PG8_SB(0, 1), cB + hstep, voffB); PG8_STAGEA(0, 1, cA, false);
        if (wr == 1) PG8_BAR;
        PG8_WAIT_V(4); PG8_BAR;
        PG8_STAGE(PG8_SB(1, 0), cB + kstep, voffB); PG8_STAGEA(1, 0, cA + kstep, false); PG8_STAGE(PG8_SB(1, 1), cB + hstep + kstep, voffB);
        PG8_WAIT_V(6); PG8_BAR;
    }
    for (;;) {
        const bool has_next = S.next(ui + 1, nxt);
        const char* nA = (has_next && !GATHER) ? (const char*)g.A + (size_t)nxt.pm * tstep : cA; if constexpr (GATHER) { if (has_next) { PG8_GOFF(vN, nxt.pm); } else {
#pragma unroll
            for (int h_ = 0; h_ < 2; ++h_) { vN[h_][0] = vA[h_][0]; vN[h_][1] = vA[h_][1]; } } }
        const char* nB = has_next ? (const char*)g.Bt + (size_t)nxt.e * g.bstride + (size_t)nxt.pn * tstep : cB;
        for (int t = 0; t < nt; t += 2) {
            const bool last = (t == nt - 2);
            const char* a1 = cA + (size_t)(t + 1) * kstep;
            const char* a2 = last ? nA : cA + (size_t)(t + 2) * kstep; const char* b2 = last ? nB : cB + (size_t)(t + 2) * kstep;
            const char* a3 = a2 + kstep; const char* b3 = b2 + kstep;
            if (last && has_next) S.a_ready(nxt);
            if (last && g.scal && wid == 0) __builtin_amdgcn_global_load_lds((const unsigned*)(g.scal + (size_t)cur.pm * BM + lane * 4), (PG8_LAS unsigned*)(uintptr_t)g.scal_lds, 16, 0, 0);
            if constexpr (SP2) {
            PG8_LDB(B0, 0, 0); PG8_LDB(B1, 0, 1); PG8_SCHED; PG8_LDA(At, 0, 0); PG8_STAGEA(1, 1, a1, false);
            PG8_WAIT_V(8); PG8_WAIT_L(0); PG8_BAR; PG8_MMA(0, 0, At, B0); PG8_MMA(0, 1, At, B1); PG8_BAR; PG8_SCHED;
            PG8_LDA(At, 0, 1); PG8_STAGE(PG8_SB(0, 0), b2, voffB); PG8_STAGE(PG8_SB(0, 1), b2 + hstep, voffB); PG8_STAGEA(0, 0, a2, last);
            PG8_WAIT_V(8); PG8_WAIT_L(0); PG8_BAR; PG8_MMA(1, 0, At, B0); PG8_MMA(1, 1, At, B1); PG8_BAR; PG8_SCHED;
            PG8_LDB(B0, 1, 0); PG8_LDB(B1, 1, 1); PG8_SCHED; PG8_LDA(At, 1, 0); PG8_STAGEA(0, 1, a2, last);
            PG8_WAIT_V(8); PG8_WAIT_L(0); PG8_BAR; PG8_MMA(0, 0, At, B0); PG8_MMA(0, 1, At, B1); PG8_BAR; PG8_SCHED;
            PG8_LDA(At, 1, 1); PG8_STAGE(PG8_SB(1, 0), b3, voffB); PG8_STAGE(PG8_SB(1, 1), b3 + hstep, voffB); PG8_STAGEA(1, 0, a3, last);
            PG8_WAIT_V(8); PG8_WAIT_L(0); PG8_BAR; PG8_MMA(1, 0, At, B0); PG8_MMA(1, 1, At, B1); PG8_BAR; PG8_SCHED;
            } else {
            PG8_LDB(B0, 0, 0); PG8_SCHED; PG8_LDA(At, 0, 0); PG8_STAGEA(1, 1, a1, false);
            PG8_WAIT_L(8); PG8_BAR; PG8_WAIT_L(0); PG8_MMA(0, 0, At, B0); PG8_BAR; PG8_SCHED;
            PG8_LDB(B1, 0, 1); PG8_STAGE(PG8_SB(0, 0), b2, voffB);
            PG8_BAR; PG8_WAIT_L(0); PG8_MMA(0, 1, At, B1); PG8_BAR;
            PG8_LDA(At, 0, 1); PG8_STAGEA(0, 0, a2, last);
            PG8_BAR; PG8_WAIT_L(0); PG8_MMA(1, 0, At, B0); PG8_BAR; PG8_SCHED;
            PG8_STAGE(PG8_SB(0, 1), b2 + hstep, voffB);
            PG8_WAIT_V(6); PG8_BAR; PG8_MMA(1, 1, At, B1); PG8_BAR;
            PG8_LDB(B0, 1, 0); PG8_SCHED; PG8_LDA(At, 1, 0); PG8_STAGEA(0, 1, a2, last);
            PG8_WAIT_L(8); PG8_BAR; PG8_WAIT_L(0); PG8_MMA(0, 0, At, B0); PG8_BAR; PG8_SCHED;
            PG8_LDB(B1, 1, 1); PG8_STAGE(PG8_SB(1, 0), b3, voffB);
            PG8_BAR; PG8_WAIT_L(0); PG8_MMA(0, 1, At, B1); PG8_BAR;
            PG8_LDA(At, 1, 1); PG8_STAGEA(1, 0, a3, last);
            PG8_BAR; PG8_WAIT_L(0); PG8_MMA(1, 0, At, B0); PG8_BAR; PG8_SCHED;
            PG8_STAGE(PG8_SB(1, 1), b3 + hstep, voffB);
            PG8_WAIT_V(6); PG8_BAR; PG8_MMA(1, 1, At, B1); PG8_BAR;
            }
        }
        if constexpr (ALIGN_EPI) { if (wr == 0) PG8_BAR; }
        if constexpr (!Epi::AFTER_DRAIN) { E(acc, cur, wr, wc, fr, fq); S.done(cur); }
        if (!has_next) break;
#pragma unroll
        for (int a = 0; a < 2; ++a)
#pragma unroll
            for (int b = 0; b < 2; ++b)
#pragma unroll
                for (int m = 0; m < 4; ++m)
#pragma unroll
                    for (int n = 0; n < 2; ++n) acc[a][b][m][n] = (f32x4){0.f, 0.f, 0.f, 0.f};
        cur = nxt; cA = nA; cB = nB; ++ui;
        if constexpr (GATHER) {
#pragma unroll
            for (int h_ = 0; h_ < 2; ++h_) { vA[h_][0] = vN[h_][0]; vA[h_][1] = vN[h_][1]; } }
        if constexpr (ALIGN_EPI) { if (wr == 1) PG8_BAR; }
    }
    PG8_WAIT_V(0);
    if constexpr (!ALIGN_EPI) { if (wr == 0) PG8_BAR; }
    PG8_BAR;
    if constexpr (Epi::AFTER_DRAIN) { E.fused(acc, cur, wr, wc, fr, fq, lds, wid, lane); S.done(cur); }
#undef PG8_SA
#undef PG8_SB
#undef PG8_STAGE
#undef PG8_LDA
#undef PG8_STAGEA
#undef PG8_GOFF
#undef PG8_LDB
#undef PG8_MMA
#undef PG8_WAIT_V
#undef PG8_WAIT_L
#undef PG8_BAR
#undef PG8_SCHED
}
}
#define GAS __attribute__((address_space(1)))
#define LAS __attribute__((address_space(3)))
typedef unsigned short bf16;
typedef unsigned v4u __attribute__((ext_vector_type(4)));
typedef float f32x4 __attribute__((ext_vector_type(4)));
typedef short bf16x8 __attribute__((ext_vector_type(8)));
typedef GAS unsigned gu32;
typedef GAS unsigned long long gu64;
#define RLX_AGENT __ATOMIC_RELAXED, __HIP_MEMORY_SCOPE_AGENT
#define LDS_WAIT() asm volatile("s_waitcnt lgkmcnt(0)" ::: "memory")
#define VM_WAIT() asm volatile("s_waitcnt vmcnt(0)" ::: "memory")
__device__ __forceinline__ unsigned long long rt() { return __builtin_amdgcn_s_memrealtime(); }
__device__ __forceinline__ unsigned f2bf(float f) { unsigned u = __builtin_bit_cast(unsigned, f); return (u + 0x7fffu + ((u >> 16) & 1u)) >> 16; }
__device__ __forceinline__ unsigned pk2(float lo, float hi) { return f2bf(lo) | (f2bf(hi) << 16); }
#define XB_TMO      128
#define XB_XCNT(j)  (256  + 64 * (j))
#define XB_XSUB(j)  (1280 + 64 * (j))
#define XB_XGEN(j)  (2304 + 64 * (j))
#define XB_TOP      3328
#define XB_TOPGEN   3392
#define XCD_BAR_WORDS 3456
#define XB_SPIN_CAP (1u << 18)

__device__ __forceinline__ unsigned xb_ld(unsigned* p)              { return __hip_atomic_load(p, __ATOMIC_RELAXED, __HIP_MEMORY_SCOPE_AGENT); }
__device__ __forceinline__ unsigned xb_add(unsigned* p, unsigned v) { return __hip_atomic_fetch_add(p, v, __ATOMIC_RELAXED, __HIP_MEMORY_SCOPE_AGENT); }
__device__ __forceinline__ unsigned xb_xcc_id() { return (unsigned)__builtin_amdgcn_s_getreg((3 << 11) | 20) & 0xFu; }
#define XB_SPIN(cond, bar) do { unsigned _sp = 0; while (cond) { __builtin_amdgcn_s_sleep(1); \
    if ((++_sp & 255u) == 0u) { if (xb_ld(&(bar)[XB_TMO])) break; if (_sp > XB_SPIN_CAP) { atomicAdd(&(bar)[XB_TMO], 1u); break; } } } } while (0)

struct XcdBarrier {
    unsigned* bar; unsigned x;
    volatile LAS unsigned* st;
};

__device__ __forceinline__ XcdBarrier xcd_barrier_post(unsigned* bar, volatile LAS unsigned* st) {
    XcdBarrier b; b.bar = bar; b.x = xb_xcc_id(); b.st = st;
    if (threadIdx.x == 0) (void)xb_add(&bar[XB_XCNT(b.x)], 1u);
    return b;
}
__device__ __forceinline__ void xcd_barrier_complete(unsigned* bar, unsigned x, unsigned& nloc, unsigned& nx) {
    const unsigned G = gridDim.x * gridDim.y * gridDim.z;
    unsigned sum, cnt, mine, sp = 0u;
    for (;;) {
        sum = 0u; cnt = 0u; mine = 0u;
#pragma unroll
        for (unsigned j = 0; j < 16; ++j) { const unsigned c = xb_ld(&bar[XB_XCNT(j)]); sum += c; cnt += (c > 0u) ? 1u : 0u; mine = (j == x) ? c : mine; }
        if (sum == G) break;
        __builtin_amdgcn_s_sleep(1);
        if ((++sp & 255u) == 0u) { if (xb_ld(&bar[XB_TMO])) break; if (sp > XB_SPIN_CAP) { atomicAdd(&bar[XB_TMO], 1u); break; } }
    }
    nloc = mine > 0u ? mine : 1u; nx = cnt > 0u ? cnt : 1u;
}

__device__ __forceinline__ void xcd_barrier(const XcdBarrier& b) {
    asm volatile("s_waitcnt vmcnt(0)" ::: "memory");
    __syncthreads();
    if (threadIdx.x == 0) {
        unsigned* bar = b.bar;
        __builtin_amdgcn_s_waitcnt(0);
        unsigned nloc = b.st[0], nx = b.st[1];
        if (nloc == 0u) { xcd_barrier_complete(bar, b.x, nloc, nx); b.st[0] = nloc; b.st[1] = nx; }
        const unsigned old = xb_add(&bar[XB_XSUB(b.x)], 1u);
        const unsigned gen = old / nloc;
        if (old + 1u == (gen + 1u) * nloc) {
            __builtin_amdgcn_fence(__ATOMIC_RELEASE, "agent");
            asm volatile("s_waitcnt vmcnt(0)" ::: "memory");
            const unsigned og = xb_add(&bar[XB_TOP], 1u);
            const unsigned tg = og / nx;
            if (og + 1u == (tg + 1u) * nx) xb_add(&bar[XB_TOPGEN], 1u);
            else XB_SPIN(xb_ld(&bar[XB_TOPGEN]) == tg, bar);
            __builtin_amdgcn_fence(__ATOMIC_ACQUIRE, "agent");
            xb_add(&bar[XB_XGEN(b.x)], 1u);
            asm volatile("s_waitcnt vmcnt(0)" ::: "memory");
        } else {
            XB_SPIN(xb_ld(&bar[XB_XGEN(b.x)]) == gen, bar);
            __builtin_amdgcn_fence(__ATOMIC_ACQUIRE, "agent");
            asm volatile("s_waitcnt vmcnt(0)" ::: "memory");
        }
    }
    __syncthreads();
}

typedef float f32x16 __attribute__((ext_vector_type(16)));
typedef float f32x2 __attribute__((ext_vector_type(2)));
typedef unsigned u32x2g __attribute__((ext_vector_type(2)));
typedef short v4i16_t __attribute__((ext_vector_type(4)));
enum { IN_X = 0, IN_RELB, IN_LN1G, IN_WIN, IN_LQ1, IN_LK1, IN_LQ2, IN_LK2, IN_SUBLN, IN_CONVW, IN_CONVB, IN_CLNG, IN_CLNB, IN_SLRE, IN_SLIM, IN_SLDT, IN_SBRE, IN_SBIM, IN_SCRE, IN_SCIM,
       IN_SD, IN_GLUW, IN_GLUB, IN_WOUT, IN_LN2G, IN_GRW, IN_GRB, IN_ERW, IN_ERB, IN_WG, IN_WU, IN_WD, IN_FING, N_IN };
struct Args { const float* in[N_IN]; float* out; unsigned char* ws; int ph_lo, ph_hi; };
struct ArgsV { const float* const* in; };
__device__ __forceinline__ ArgsV args_view() { const float* const* p = (const float* const*)__builtin_amdgcn_kernarg_segment_ptr(); asm volatile("" : "+s"(p)); return ArgsV{p}; }
#define UNIT_IDS int tid_u_ = threadIdx.x; asm volatile("" : "+v"(tid_u_)); const int tid = tid_u_, lane = tid & 63, wave = __builtin_amdgcn_readfirstlane(tid >> 6); (void)tid; (void)lane; (void)wave
struct Frame {
    LAS unsigned char* lds; volatile LAS unsigned* MISC; gu32* ctl;
    int tid, lane, wave, vcu, G;
    unsigned char* ws; float* out;
};
__device__ __forceinline__ unsigned pkb(float lo, float hi) { return pg8::pk_bf16(lo, hi); }
__device__ __forceinline__ float bf2f(unsigned short b) { return __builtin_bit_cast(float, (unsigned)b << 16); }
__device__ __forceinline__ float bflo(unsigned w) { return __builtin_bit_cast(float, w << 16); }
__device__ __forceinline__ float bfhi(unsigned w) { return __builtin_bit_cast(float, w & 0xffff0000u); }
__device__ __forceinline__ float wave_sum(float v) {
#pragma unroll
    for (int o = 1; o < 64; o <<= 1) v += __shfl_xor(v, o);
    return v;
}
__device__ __forceinline__ float sigmoidf_(float x) { return __builtin_amdgcn_rcpf(1.0f + __builtin_amdgcn_exp2f(-LOG2E * x)); }
__device__ __forceinline__ float gelu_tanh(float y) {
    const float u2 = 1.5957691216057308f * (y + 0.044715f * y * y * y);
    return y * sigmoidf_(u2);
}

struct TrDesc { const float* src; const float* gain; bf16* dst; int N, K; };
__device__ __forceinline__ TrDesc tr_desc(const ArgsV& A, unsigned char* ws, int it) {
    constexpr int I_SMALL = 1152 + 512 + 32, I_EXP = 768;
    TrDesc d;
    if (it < 2 * I_SMALL) {
        const int l = it / I_SMALL; int r = it % I_SMALL;
        if (r < 1152) { const int kb = r / 72, nb = r % 72; d.N = NCOL; d.K = DM; d.src = A.in[IN_WIN] + (size_t)l * DM * NCOL + (size_t)(64 * kb) * NCOL + 32 * nb; d.gain = A.in[IN_LN1G] + l * DM + 64 * kb;
            const int tl_ = nb >> 3, tp_ = (tl_ == 8) ? 6 : (tl_ >= 6 ? tl_ + 1 : tl_);
            d.dst = (bf16*)(ws + WS_WIN) + (size_t)l * NCOL * DM + (size_t)(32 * (tp_ * 8 + (nb & 7))) * DM + 64 * kb; return d; }
        r -= 1152;
        if (r < 512) { const int kb = r / 32, nb = r % 32; d.N = DM; d.K = DM; d.src = A.in[IN_WOUT] + (size_t)l * DM * DM + (size_t)(64 * kb) * DM + 32 * nb; d.gain = nullptr;
            d.dst = (bf16*)(ws + WS_WOUT) + (size_t)l * DM * DM + (size_t)(32 * nb) * DM + 64 * kb; return d; }
        r -= 512;
        { const int kb = r / 8, nb = r % 8; d.N = 256; d.K = 256; d.src = A.in[IN_GLUW] + (size_t)l * 256 * 256 + (size_t)(64 * kb) * 256 + 32 * nb; d.gain = nullptr;
            d.dst = (bf16*)(ws + WS_WGLU) + (size_t)l * 256 * 256 + (size_t)(32 * nb) * 256 + 64 * kb; return d; }
    }
    const int r = it - 2 * I_SMALL, le = r / I_EXP, q = r % I_EXP, l = le / NE, mat = q >> 8, idx = q & 255;
    if (mat < 2) { const int kb = idx >> 4, nb = idx & 15, n0 = 32 * nb; d.N = FF; d.K = DM; d.src = A.in[mat == 0 ? IN_WG : IN_WU] + (size_t)le * DM * FF + (size_t)(64 * kb) * FF + n0; d.gain = A.in[IN_LN2G] + l * DM + 64 * kb;
        d.dst = (bf16*)(ws + WS_WGU) + (size_t)le * 1024 * 1024 + (size_t)((n0 >> 7) * 256 + (n0 & 127) + (mat ? 128 : 0)) * DM + 64 * kb; return d; }
    { const int kb = idx >> 5, nb = idx & 31; d.N = DM; d.K = FF; d.src = A.in[IN_WD] + (size_t)le * FF * DM + (size_t)(64 * kb) * DM + 32 * nb; d.gain = nullptr;
        d.dst = (bf16*)(ws + WS_WDN) + (size_t)le * DM * FF + (size_t)(32 * nb) * FF + 64 * kb; return d; }
}
__device__ __forceinline__ void tr_load(const TrDesc& d, float (&v)[32], int lane) {
    const float* p = d.src + (size_t)(lane >> 5) * d.N + (lane & 31);
#pragma unroll
    for (int i = 0; i < 32; ++i) v[i] = __builtin_nontemporal_load(p + (size_t)(2 * i) * d.N);
}
__device__ __forceinline__ void tr_finish(const TrDesc& d, const float (&v)[32], LAS float* scr, int lane) {
#pragma unroll
    for (int i = 0; i < 32; ++i) scr[(2 * i + (lane >> 5)) * 33 + (lane & 31)] = v[i];
    LDS_WAIT(); asm volatile("" ::: "memory");
    const int c = lane & 7;
    f32x4 g0 = {1.f, 1.f, 1.f, 1.f}, g1 = {1.f, 1.f, 1.f, 1.f};
    if (d.gain) { g0 = *(const GAS f32x4*)(d.gain + 8 * c); g1 = *(const GAS f32x4*)(d.gain + 8 * c + 4); }
#pragma unroll
    for (int j = 0; j < 4; ++j) { const int n = (lane >> 3) + 8 * j; const LAS float* s = scr + (8 * c) * 33 + n;
        v4u o; o.x = pkb(s[0 * 33] * g0.x, s[1 * 33] * g0.y); o.y = pkb(s[2 * 33] * g0.z, s[3 * 33] * g0.w); o.z = pkb(s[4 * 33] * g1.x, s[5 * 33] * g1.y); o.w = pkb(s[6 * 33] * g1.z, s[7 * 33] * g1.w);
        *(GAS v4u*)(d.dst + (size_t)n * d.K + 8 * c) = o; }
    LDS_WAIT(); asm volatile("" ::: "memory");
}
__device__ __forceinline__ void convert_items(Frame& F, const ArgsV& A, int it0, int it1) {
    LAS float* scr = (LAS float*)(F.lds + RING_OFF + F.wave * 16384);
    const int gw = F.vcu * 8 + F.wave, NGW = F.G * 8, lane = F.lane;
    unsigned char* ws = F.ws;
    int it = it0 + gw;
    if (it < it1) { TrDesc cur = tr_desc(A, ws, it); float va[32], vb[32]; tr_load(cur, va, lane);
#pragma unroll 1
        for (;;) {
            const int it1_ = it + NGW; TrDesc nx; const bool h1 = it1_ < it1; if (h1) { nx = tr_desc(A, ws, it1_); tr_load(nx, vb, lane); }
            tr_finish(cur, va, scr, lane);
            if (!h1) break;
            const int it2 = it1_ + NGW; const bool h2 = it2 < it1; if (h2) { cur = tr_desc(A, ws, it2); tr_load(cur, va, lane); }
            tr_finish(nx, vb, scr, lane);
            if (!h2) break;
            it = it2; } }
}
__device__ __forceinline__ void p0_prologue(Frame& F, const ArgsV& A) {
    LAS float* scr = (LAS float*)(F.lds + RING_OFF + F.wave * 16384);
    const int gw = F.vcu * 8 + F.wave, NGW = F.G * 8, lane = F.lane;
    unsigned char* ws = F.ws;
    convert_items(F, A, 0, 2 * (1152 + 512 + 32));
    const int gt = F.vcu * 512 + F.tid, NGT = F.G * 512;
    for (int i = gt; i < 2 * 64 * 1024; i += NGT) {
        const int l = i >> 16, n = (i >> 10) & 63, k = i & 1023; float v = 0.f; const float g = A.in[IN_LN2G][l * DM + k];
        if (n < 32) v = A.in[IN_ERW][((size_t)l * DM + k) * 32 + n] * g; else if (n < 36) v = A.in[IN_GRW][((size_t)l * DM + k) * 4 + (n - 32)] * g;
        ((bf16*)(ws + WS_WRT))[i] = (bf16)f2bf(v);
    }
    for (int i = gt; i < 2 * 1024; i += NGT) {
        const int l = i >> 10, gp = i & 1023, g = gp >> 6;
        float* P = (float*)(ws + MS_SSMP) + (size_t)l * SP_END;
        const float dt = expf(A.in[IN_SLDT][l * 16 + g]), lr = A.in[IN_SLRE][l * 1024 + gp], li = A.in[IN_SLIM][l * 1024 + gp];
        const float mag = expf(lr * dt), ar = mag * cosf(li * dt), ai = mag * sinf(li * dt), den = lr * lr + li * li;
        const float zr = ((ar - 1.0f) * lr + ai * li) / den, zi = (ai * lr - (ar - 1.0f) * li) / den;
        P[SP_AR + gp] = ar; P[SP_AI + gp] = ai;
        float pr = ar, pi = ai;
#pragma unroll
        for (int s = 0; s < 7; ++s) { const float nr = pr * pr - pi * pi, ni = 2.0f * pr * pi; pr = nr; pi = ni; }
        P[SP_ARL + gp] = pr; P[SP_AIL + gp] = pi;
        for (int h = 0; h < 16; ++h) { const float bre = A.in[IN_SBRE][((size_t)l * 1024 + gp) * 16 + h], bim = A.in[IN_SBIM][((size_t)l * 1024 + gp) * 16 + h];
            P[SP_BBR + gp * 16 + h] = zr * bre - zi * bim; P[SP_BBI + gp * 16 + h] = zr * bim + zi * bre; }
    }
    for (int i = gt; i < 2 * 16 * 16 * 128; i += NGT) {
        const int l = i >> 15, g = (i >> 11) & 15, h = (i >> 7) & 15, pp = i & 127;
        const float v = pp < 64 ? A.in[IN_SCRE][(((size_t)l * 16 + g) * 16 + h) * 64 + pp] : -A.in[IN_SCIM][(((size_t)l * 16 + g) * 16 + h) * 64 + (pp - 64)];
        ((bf16*)(ws + MS_SSMC))[i] = (bf16)f2bf(v);
    }
    for (int i = gt; i < 4 * 132; i += NGT) {
        const int h = i / 132, n = i % 132; int bucket;
        if (n < 16) bucket = n; else if (n >= 128) bucket = 31; else { const float nf = (float)n; int lg = 16 + (int)(logf(nf / 16.0f) / 2.0794415416798357f * 16.0f); bucket = lg < 31 ? lg : 31; }
        ((float*)(ws + MS_LUT))[i] = A.in[IN_RELB][bucket * 4 + h] * LOG2E;
    }
    if (gt < 2) { const int l = gt; float s1 = 0.f, s2 = 0.f;
        for (int d = 0; d < 64; ++d) { s1 += A.in[IN_LQ1][l * 64 + d] * A.in[IN_LK1][l * 64 + d]; s2 += A.in[IN_LQ2][l * 64 + d] * A.in[IN_LK2][l * 64 + d]; }
        const float lam_init = 0.8f - 0.6f * expf(-0.3f * (float)l);
        ((float*)(ws + MS_LAM))[l] = expf(s1) - expf(s2) + lam_init; ((float*)(ws + MS_LAM))[2 + l] = 1.0f - lam_init; }
    for (int m = gw; m < NTOK; m += NGW) {
        const GAS f32x4* xr = (const GAS f32x4*)(A.in[IN_X] + (size_t)m * DM) + lane; float s = 0.f;
        GAS unsigned long long* o8 = (GAS unsigned long long*)((bf16*)(ws + WS_XB) + (size_t)m * DM) + lane;
#pragma unroll
        for (int j = 0; j < 4; ++j) { const f32x4 v = xr[64 * j]; s += (v.x * v.x + v.y * v.y) + (v.z * v.z + v.w * v.w);
            o8[64 * j] = (unsigned long long)pkb(v.x, v.y) | ((unsigned long long)pkb(v.z, v.w) << 32); }
        s = wave_sum(s); if (lane == 0) ((float*)(ws + MS_ROWSS))[m] = s;
    }
}

constexpr int US_STRIDE = 528;
struct URaw { v4u a, b; };
__device__ __forceinline__ URaw ssm_fetch_u(Frame& F, int tok0, int tid) {
    const int row = tid >> 4, ch = (tid & 15) * 16;
    const bf16* src = (const bf16*)(F.ws + WS_PROJ) + (size_t)(tok0 + row) * NCOLP + COL_SSM + ch;
    URaw r; r.a = *(const GAS v4u*)src; r.b = *(const GAS v4u*)(src + 8); return r;
}
__device__ __forceinline__ void ssm_store_u(Frame& F, const URaw& r, int tid) {
    const int row = tid >> 4, ch = (tid & 15) * 16;
    LAS v4u* d = (LAS v4u*)(F.lds + row * US_STRIDE + ch * 2); d[0] = r.a; d[1] = r.b;
}
__device__ __forceinline__ bf16x8 ssm_bfrag(const float* P, int off, int g, int p, int hi) {
    const GAS f32x4* s4 = (const GAS f32x4*)(P + off + (g * 64 + p) * 16 + 8 * hi); const f32x4 a = s4[0], b = s4[1];
    v4u t; t.x = pkb(a.x, a.y); t.y = pkb(a.z, a.w); t.z = pkb(b.x, b.y); t.w = pkb(b.z, b.w); return __builtin_bit_cast(bf16x8, t);
}
struct SsmBu { f32x16 rx, ry, ix, iy; };
__device__ __forceinline__ void ssm_bu(SsmBu& o, const LAS unsigned char* Ub, int g, int r32, int hi, const bf16x8 (&bf)[4]) {
    const bf16x8 u1 = *(const LAS bf16x8*)(Ub + r32 * US_STRIDE + g * 32 + hi * 16);
    const bf16x8 u2 = *(const LAS bf16x8*)(Ub + (r32 ^ 4) * US_STRIDE + g * 32 + hi * 16);
    f32x16 z;
#pragma unroll
    for (int r = 0; r < 16; ++r) z[r] = 0.f;
#define SSM_SEL(dst, fa, fb, swapd) do { const f32x16 m1_ = __builtin_amdgcn_mfma_f32_32x32x16_bf16(u1, fa, z, 0, 0, 0), m2_ = __builtin_amdgcn_mfma_f32_32x32x16_bf16(u2, fb, z, 0, 0, 0); \
        _Pragma("unroll") for (int r = 0; r < 16; ++r) dst[r] = (swapd) ? (hi ? m1_[r] : m2_[r]) : (hi ? m2_[r] : m1_[r]); asm volatile("" : "+v"(dst)); __builtin_amdgcn_sched_barrier(0); } while (0)
    SSM_SEL(o.rx, bf[0], bf[1], false);
    SSM_SEL(o.ry, bf[1], bf[0], true);
    SSM_SEL(o.ix, bf[2], bf[3], false);
    SSM_SEL(o.iy, bf[3], bf[2], true);
#undef SSM_SEL
}
#define SSM_BUR(o, t) ((((t) & 7) < 4) ? (o).rx[4 * ((t) >> 3) + ((t) & 3)] : (o).ry[4 * ((t) >> 3) + ((t) & 3)])
#define SSM_BUI(o, t) ((((t) & 7) < 4) ? (o).ix[4 * ((t) >> 3) + ((t) & 3)] : (o).iy[4 * ((t) >> 3) + ((t) & 3)])
__device__ __forceinline__ void ssmA_unit(Frame& F, int l, int u) {
    UNIT_IDS;
    const int b = u / SSM_NRUN, r = u % SSM_NRUN, tok0 = b * SEQ + r * SSM_RUN, r32 = lane & 31, hi = lane >> 5;
    const float* P = (const float*)(F.ws + MS_SSMP) + (size_t)l * SP_END; const LAS unsigned char* Ub = (const LAS unsigned char*)(F.lds);
    bf16x8 bfr[2][4]; float ar[2], ai[2], sr[2] = {0.f, 0.f}, si[2] = {0.f, 0.f};
#pragma unroll
    for (int gi = 0; gi < 2; ++gi) { const int g = wave * 2 + gi; ar[gi] = P[SP_AR + g * 64 + lane]; ai[gi] = P[SP_AI + g * 64 + lane];
        bfr[gi][0] = ssm_bfrag(P, SP_BBR, g, r32, hi); bfr[gi][1] = ssm_bfrag(P, SP_BBR, g, r32 + 32, hi); bfr[gi][2] = ssm_bfrag(P, SP_BBI, g, r32, hi); bfr[gi][3] = ssm_bfrag(P, SP_BBI, g, r32 + 32, hi); }
    { const URaw raw = ssm_fetch_u(F, tok0, tid); ssm_store_u(F, raw, tid); }
    __syncthreads();
#pragma unroll 1
    for (int sc = 0; sc < 4; ++sc) {
        URaw raw; if (sc < 3) raw = ssm_fetch_u(F, tok0 + (sc + 1) * 32, tid);
#pragma unroll
        for (int gi = 0; gi < 2; ++gi) { SsmBu bu; ssm_bu(bu, Ub, wave * 2 + gi, r32, hi, bfr[gi]);
#pragma unroll
            for (int t = 0; t < 32; ++t) { float t1 = __builtin_fmaf(-ai[gi], si[gi], SSM_BUR(bu, t)); asm volatile("" : "+v"(t1));
                const float nr = __builtin_fmaf(ar[gi], sr[gi], t1), ni = __builtin_fmaf(ar[gi], si[gi], __builtin_fmaf(ai[gi], sr[gi], SSM_BUI(bu, t))); sr[gi] = nr; si[gi] = ni; }
            __builtin_amdgcn_sched_barrier(0); }
        __syncthreads();
        if (sc < 3) { ssm_store_u(F, raw, tid); __syncthreads(); }
    }
    GAS f32x2* S = (GAS f32x2*)(F.ws + WS_SSM) + (((size_t)(b * SSM_NRUN + r)) * 16 + wave * 2) * 64 + lane;
    S[0] = (f32x2){sr[0], si[0]}; S[64] = (f32x2){sr[1], si[1]};
}
__device__ __forceinline__ void conv_unit(Frame& F, const ArgsV& A, int l, int u) {
    UNIT_IDS;
    const int b = u >> 7, t0 = (u & 127) * 64;
    LAS float* H = (LAS float*)(F.lds);
    const bf16* PR = (const bf16*)(F.ws + WS_PROJ) + (size_t)b * SEQ * NCOLP;
    const int c = tid & 255, half = tid >> 8;
    float w[31];
#pragma unroll
    for (int k = 0; k < 31; ++k) w[k] = A.in[IN_CONVW][((size_t)l * 31 + k) * 256 + c];
    const float bias = A.in[IN_CONVB][l * 256 + c];
    const f32x4 lg = *(const GAS f32x4*)(A.in[IN_CLNG] + l * 256 + lane * 4), lb = *(const GAS f32x4*)(A.in[IN_CLNB] + l * 256 + lane * 4);
    { v4u av[6], gv[6]; const int c8 = (tid & 31) * 8;
#pragma unroll
      for (int pass = 0; pass < 6; ++pass) { const int r = pass * 16 + (tid >> 5), t = t0 - 30 + r; av[pass] = (v4u){0u, 0u, 0u, 0u}; gv[pass] = av[pass];
          if (r < 94 && t >= 0) { const bf16* src = PR + (size_t)t * NCOLP + COL_CONV + c8; av[pass] = *(const GAS v4u*)src; gv[pass] = *(const GAS v4u*)(src + 256); } }
#pragma unroll
      for (int pass = 0; pass < 6; ++pass) { const int r = pass * 16 + (tid >> 5);
          if (r < 94) { const v4u a = av[pass], g = gv[pass];
              const f32x4 h0 = (f32x4){bflo(a.x) * sigmoidf_(bflo(g.x)), bfhi(a.x) * sigmoidf_(bfhi(g.x)), bflo(a.y) * sigmoidf_(bflo(g.y)), bfhi(a.y) * sigmoidf_(bfhi(g.y))};
              const f32x4 h1 = (f32x4){bflo(a.z) * sigmoidf_(bflo(g.z)), bfhi(a.z) * sigmoidf_(bfhi(g.z)), bflo(a.w) * sigmoidf_(bflo(g.w)), bfhi(a.w) * sigmoidf_(bfhi(g.w))};
              LAS f32x4* d = (LAS f32x4*)(H + r * 256 + c8); d[0] = h0; d[1] = h1; } } }
    __syncthreads();
    float acc[32];
#pragma unroll
    for (int tb = 0; tb < 4; ++tb) { float hv[38];
#pragma unroll
        for (int i = 0; i < 38; ++i) hv[i] = H[(half * 32 + tb * 8 + i) * 256 + c];
#pragma unroll
        for (int o = 0; o < 8; ++o) { float a = bias;
#pragma unroll
            for (int k = 0; k < 31; ++k) a += w[k] * hv[o + k];
            acc[tb * 8 + o] = a; } }
    __syncthreads();
#pragma unroll
    for (int i = 0; i < 32; ++i) H[(half * 32 + i) * 256 + c] = acc[i];
    __syncthreads();
    bf16* MX = (bf16*)(F.ws + WS_MIX) + ((size_t)b * SEQ + t0) * DM + 512 + lane * 4;
#pragma unroll 2
    for (int i = 0; i < 8; ++i) { const int tk = wave * 8 + i; const f32x4 v = *(const LAS f32x4*)(H + tk * 256 + lane * 4);
        const float mean = wave_sum((v.x + v.y) + (v.z + v.w)) * (1.0f / 256.0f); const f32x4 d = v - mean;
        const float var = wave_sum((d.x * d.x + d.y * d.y) + (d.z * d.z + d.w * d.w)) * (1.0f / 256.0f); const float rstd = __builtin_amdgcn_rsqf(var + LN_EPS_C);
        f32x4 y = d * rstd * lg + lb; y = (f32x4){y.x * sigmoidf_(y.x), y.y * sigmoidf_(y.y), y.z * sigmoidf_(y.z), y.w * sigmoidf_(y.w)};
        u32x2g o; o.x = pkb(y.x, y.y); o.y = pkb(y.z, y.w); *(GAS u32x2g*)(MX + (size_t)tk * DM) = o; }
    __syncthreads();
}
constexpr int XS_STRIDE = 136, XS_WAVE = 32 * XS_STRIDE;
constexpr int GT_STRIDE = 264;
constexpr int SSMC_XS_OFF = 32768, SSMC_GT_OFF = SSMC_XS_OFF + 8 * XS_WAVE * 2;
static_assert(SSMC_GT_OFF + 32 * GT_STRIDE * 2 <= RING_BYTES, "SSM-C LDS");
__device__ __forceinline__ void ssmC_unit(Frame& F, const ArgsV& A, int l, int u) {
    UNIT_IDS;
    const int b = u / SSM_NRUN, r = u % SSM_NRUN, tok0 = b * SEQ + r * SSM_RUN, fr = lane & 15, fq = lane >> 4;
    const float* P = (const float*)(F.ws + MS_SSMP) + (size_t)l * SP_END; const LAS unsigned char* Ub = (const LAS unsigned char*)(F.lds); const int r32 = lane & 31, hi = lane >> 5;
    LAS bf16* Xs = (LAS bf16*)(F.lds + SSMC_XS_OFF) + wave * XS_WAVE; LAS bf16* Gt = (LAS bf16*)(F.lds + SSMC_GT_OFF);
    const bf16* Cm = (const bf16*)(F.ws + MS_SSMC) + (size_t)l * 16 * 16 * 128;
    const bf16* WG = (const bf16*)(F.ws + WS_WGLU) + (size_t)l * 256 * 256;
    { const URaw raw = ssm_fetch_u(F, tok0, tid); ssm_store_u(F, raw, tid); }
    bf16x8 bfr[2][4]; float ar[2], ai[2];
#pragma unroll
    for (int gi = 0; gi < 2; ++gi) { const int g = wave * 2 + gi; ar[gi] = P[SP_AR + g * 64 + lane]; ai[gi] = P[SP_AI + g * 64 + lane];
        bfr[gi][0] = ssm_bfrag(P, SP_BBR, g, r32, hi); bfr[gi][1] = ssm_bfrag(P, SP_BBR, g, r32 + 32, hi); bfr[gi][2] = ssm_bfrag(P, SP_BBI, g, r32, hi); bfr[gi][3] = ssm_bfrag(P, SP_BBI, g, r32 + 32, hi); }
    float xr[2] = {0.f, 0.f}, xi[2] = {0.f, 0.f};
    { float arL[2], aiL[2], dvs_[2]; const GAS f32x2* Sp[2];
#pragma unroll
      for (int gi = 0; gi < 2; ++gi) { const int g = wave * 2 + gi; arL[gi] = P[SP_ARL + g * 64 + lane]; aiL[gi] = P[SP_AIL + g * 64 + lane];
          Sp[gi] = (const GAS f32x2*)(F.ws + WS_SSM) + (((size_t)b * SSM_NRUN) * 16 + g) * 64 + lane; }
#pragma unroll 1
      for (int j0 = 0; j0 < r; j0 += 8) {
          f32x2 sv[2][8];
#pragma unroll
          for (int gi = 0; gi < 2; ++gi)
#pragma unroll
              for (int jj = 0; jj < 8; ++jj) { const int j = (j0 + jj < r) ? j0 + jj : r - 1; sv[gi][jj] = Sp[gi][(size_t)j * 1024]; }
#pragma unroll
          for (int jj = 0; jj < 8; ++jj) if (j0 + jj < r) {
#pragma unroll
              for (int gi = 0; gi < 2; ++gi) { const float nr = arL[gi] * xr[gi] - aiL[gi] * xi[gi] + sv[gi][jj].x, ni = arL[gi] * xi[gi] + aiL[gi] * xr[gi] + sv[gi][jj].y; xr[gi] = nr; xi[gi] = ni; } } }
      (void)dvs_; }
    bf16x8 cfr2[2][4];
#pragma unroll
    for (int gi = 0; gi < 2; ++gi)
#pragma unroll
        for (int s = 0; s < 4; ++s) cfr2[gi][s] = *(const GAS bf16x8*)(Cm + ((size_t)((wave * 2 + gi) * 16 + fr)) * 128 + 32 * s + 8 * fq);
    float dvs2[2], gb2[2];
#pragma unroll
    for (int gi = 0; gi < 2; ++gi) { dvs2[gi] = A.in[IN_SD][l * 256 + (wave * 2 + gi) * 16 + fr]; gb2[gi] = A.in[IN_GLUB][l * 256 + (wave * 2 + gi) * 16 + fr]; }
    __syncthreads();
#pragma unroll 1
    for (int sc = 0; sc < 4; ++sc) {
        URaw raw; if (sc < 3) raw = ssm_fetch_u(F, tok0 + (sc + 1) * 32, tid);
#pragma unroll
        for (int gi = 0; gi < 2; ++gi) { const int g = wave * 2 + gi;
            const bf16x8 (&cfr)[4] = cfr2[gi];
            { SsmBu bu; ssm_bu(bu, Ub, g, r32, hi, bfr[gi]);
#pragma unroll
              for (int t = 0; t < 32; ++t) { float t1 = __builtin_fmaf(-ai[gi], xi[gi], SSM_BUR(bu, t)); asm volatile("" : "+v"(t1));
                  const float nr = __builtin_fmaf(ar[gi], xr[gi], t1), ni = __builtin_fmaf(ar[gi], xi[gi], __builtin_fmaf(ai[gi], xr[gi], SSM_BUI(bu, t))); xr[gi] = nr; xi[gi] = ni;
                  const unsigned pk = pkb(nr, ni); Xs[t * XS_STRIDE + lane] = (bf16)(pk & 0xffffu); Xs[t * XS_STRIDE + 64 + lane] = (bf16)(pk >> 16); } }
            LDS_WAIT(); asm volatile("" ::: "memory");
            f32x4 acc[2] = {{0.f, 0.f, 0.f, 0.f}, {0.f, 0.f, 0.f, 0.f}};
#pragma unroll
            for (int s = 0; s < 4; ++s)
#pragma unroll
                for (int tb = 0; tb < 2; ++tb) { const bf16x8 afr = *(const LAS bf16x8*)(Xs + (16 * tb + fr) * XS_STRIDE + 32 * s + 8 * fq); acc[tb] = __builtin_amdgcn_mfma_f32_16x16x32_bf16(afr, cfr[s], acc[tb], 0, 0, 0); }
            const int ch = g * 16 + fr; const float dvs = dvs2[gi];
#pragma unroll
            for (int tb = 0; tb < 2; ++tb)
#pragma unroll
                for (int q = 0; q < 4; ++q) { const int t = 16 * tb + 4 * fq + q; const float y = acc[tb][q] + dvs * bf2f(*(const LAS bf16*)(Ub + t * US_STRIDE + ch * 2)); Gt[t * GT_STRIDE + ch] = (bf16)f2bf(gelu_tanh(y)); }
            LDS_WAIT(); asm volatile("" ::: "memory"); }
        bf16x8 w0[8], w1[8];
#pragma unroll
        for (int s = 0; s < 8; ++s) { w0[s] = *(const GAS bf16x8*)(WG + (size_t)(16 * (wave * 2) + fr) * 256 + 32 * s + 8 * fq); w1[s] = *(const GAS bf16x8*)(WG + (size_t)(16 * (wave * 2 + 1) + fr) * 256 + 32 * s + 8 * fq); }
        __syncthreads();
        if (sc < 3) ssm_store_u(F, raw, tid);
        bf16* MX = (bf16*)(F.ws + WS_MIX) + (size_t)(tok0 + sc * 32) * DM + 768;
#pragma unroll
        for (int nbi = 0; nbi < 2; ++nbi) { const int nb = wave * 2 + nbi; f32x4 acc[2] = {{0.f, 0.f, 0.f, 0.f}, {0.f, 0.f, 0.f, 0.f}};
#pragma unroll
            for (int s = 0; s < 8; ++s) { const bf16x8 bfr = nbi ? w1[s] : w0[s];
#pragma unroll
                for (int tb = 0; tb < 2; ++tb) { const bf16x8 afr = *(const LAS bf16x8*)(Gt + (16 * tb + fr) * GT_STRIDE + 32 * s + 8 * fq); acc[tb] = __builtin_amdgcn_mfma_f32_16x16x32_bf16(afr, bfr, acc[tb], 0, 0, 0); } }
            const int n = 16 * nb + fr; const float gb = gb2[nbi];
#pragma unroll
            for (int tb = 0; tb < 2; ++tb)
#pragma unroll
                for (int q = 0; q < 4; ++q) { const int t = 16 * tb + 4 * fq + q; const float gv = bf2f(Gt[t * GT_STRIDE + n]); MX[(size_t)t * DM + n] = (bf16)f2bf(gv * sigmoidf_(acc[tb][q] + gb)); } }
        __syncthreads();
    }
}

#ifndef AT_STAGGER
#define AT_STAGGER 1
#endif
#ifndef AT_PIPE
#define AT_PIPE 1
#endif
#ifndef AT_VD
#define AT_VD 3
#endif
constexpr int AT_STAGE = 32768, AT_NS = 4, AT_EX_OFF = 65536;
constexpr float AT_CLAMP = 100.0f, AT_NEG = -1.0e30f;
__device__ __forceinline__ f32x16 mfma32(bf16x8 a, bf16x8 b, f32x16 c) { return __builtin_amdgcn_mfma_f32_32x32x16_bf16(a, b, c, 0, 0, 0); }
__device__ __forceinline__ void glds16(const void* gsrc, unsigned lds_dst) { unsigned keep;
    asm volatile("s_mov_b32 %0, m0\n\ts_mov_b32 m0, %2\n\ts_nop 0\n\tglobal_load_lds_dwordx4 %1, off\n\ts_mov_b32 m0, %0" : "=&s"(keep) : "v"(gsrc), "s"(lds_dst) : "memory"); }
#define AT_WAITBAR(N) asm volatile("s_waitcnt vmcnt(" #N ") lgkmcnt(0)\n\ts_barrier" ::: "memory")
template <int VAR> __device__ __forceinline__ void attn_unit(Frame& F, const ArgsV& A, int l, int b, int h, int qi, bool pre, int nbh) {
    int tid_ = threadIdx.x; asm volatile("" : "+v"(tid_));
    const int tid = tid_, lane = tid & 63, w = __builtin_amdgcn_readfirstlane(tid >> 6), r32 = lane & 31, hi = lane >> 5, map = w >> 2, rg = w & 3;
    const bf16* PR = (const bf16*)(F.ws + WS_PROJ) + (size_t)b * SEQ * NCOLP;
    const int q0 = qi * 128, qw = q0 + rg * 32, nt = 2 * qi + 2;
    LAS unsigned char* lds = F.lds; LAS float* lut = (LAS float*)(lds + LUT_OFF);
    const unsigned lds0 = (unsigned)(uintptr_t)lds;
    const char* kvsrc = (const char*)(F.ws + WS_KVH) + ((size_t)((b * 4 + h) * 128) << 15) + w * 1024 + lane * 16;
    const unsigned dma_base = lds0 + (unsigned)w * 1024u;
#define AT_DMA(j, stoff) do { const char* s_ = kvsrc + ((size_t)(j) << 15); const unsigned d_ = (unsigned)__builtin_amdgcn_readfirstlane(dma_base + (stoff)); \
        glds16(s_, d_); glds16(s_ + 8192, d_ + 8192u); glds16(s_ + 16384, d_ + 16384u); glds16(s_ + 24576, d_ + 24576u); } while (0)
    if (!pre) { AT_DMA(0, 0); AT_DMA(1, AT_STAGE); } if (!AT_STAGGER && !AT_PIPE && nt > 2) AT_DMA(2, 2 * AT_STAGE);
    if (tid < 384) { const int rel = tid - 127; lut[tid] = rel < 0 ? AT_NEG : ((const float*)(F.ws + MS_LUT))[h * 132 + (rel > 128 ? 128 : rel)]; }
    bf16x8 qf[4];
    { const bf16* qp = PR + (size_t)(qw + r32) * NCOLP + COL_Q + map * 256 + h * 64 + hi * 8;
#pragma unroll
      for (int s = 0; s < 4; ++s) qf[s] = *(const GAS bf16x8*)(qp + 16 * s); }
    float m = 0.f, lsum = 0.f; f32x16 o[4]; const float cfar = ((const float*)(F.ws + MS_LUT))[h * 132 + 128];
#pragma unroll
    for (int d = 0; d < 4; ++d)
#pragma unroll
        for (int r = 0; r < 16; ++r) o[d][r] = 0.f;
    const unsigned ksw = (unsigned)((r32 >> 1) & 7);
    const unsigned kb0 = (unsigned)map * 8192u + (unsigned)r32 * 128u + ((((unsigned)hi) ^ ksw) << 4);
    const unsigned vq = (unsigned)((lane & 15) >> 2), vchb = (unsigned)(2 * ((lane >> 4) & 1) + ((lane & 3) >> 1)), vsub = (unsigned)((lane & 1) * 8);
    const unsigned va0 = 16384u + (4u * hi + vq) * 256u + ((vq << 6) | ((vchb ^ (unsigned)hi) << 4)) + vsub;
    const unsigned vb0 = 16384u + (4u * hi + vq + 8u) * 256u + ((vq << 6) | ((vchb ^ ((unsigned)hi + 2u)) << 4)) + vsub;
    f32x16 p0, p1, cinit; v4i16_t vl[16], vh[16]; bf16x8 pf[4], kf[8];
#pragma unroll
    for (int r = 0; r < 16; ++r) cinit[r] = cfar;
#define AT_ST(t) ((unsigned)((t) & 3) * (unsigned)AT_STAGE)
#define AT_KRD(s, kb) (*(const LAS bf16x8*)(lds + ((ka ^ ((unsigned)(s) << 5)) + (kb) * 4096u)))
#define AT_VRD(i) do { vl[i] = __builtin_amdgcn_ds_read_tr16_b64_v4i16((LAS v4i16_t*)(lds + ((vaa ^ ((unsigned)((i) & 3) << 6)) + ((i) >> 2) * 4096u))); \
                       vh[i] = __builtin_amdgcn_ds_read_tr16_b64_v4i16((LAS v4i16_t*)(lds + ((vba ^ ((unsigned)((i) & 3) << 6)) + ((i) >> 2) * 4096u))); } while (0)
#if AT_STAGGER
#define AT_SYNC() do { if (j + 1 < nt) AT_WAITBAR(4); else AT_WAITBAR(0); if (j + 2 < nt) AT_DMA(j + 2, AT_ST(j + 2)); } while (0)
#else
#define AT_SYNC() do { if (j + 2 < nt) AT_WAITBAR(4); else AT_WAITBAR(0); if (VAR != 10 && j + 3 < nt) AT_DMA(j + 3, AT_ST(j + 3)); } while (0)
#endif
#define AT_KADDR(t) unsigned ka; { unsigned stv = AT_ST(t); asm volatile("" : "+v"(stv)); ka = stv + kb0; }
#define AT_QK(t) do { \
        if ((t) >= nt - 4) {                                                            \
            const LAS float* lp = lut + ((qw + r32) - (64 * (t) + 4 * hi) + 68);        \
            _Pragma("unroll") for (int r = 0; r < 16; ++r) { p0[r] = lp[59 - ((r & 3) + 8 * (r >> 2))] - m; p1[r] = lp[27 - ((r & 3) + 8 * (r >> 2))] - m; } \
            _Pragma("unroll") for (int s = 0; s < 4; ++s) { p0 = mfma32(kf[2 * s], qf[s], p0); p1 = mfma32(kf[2 * s + 1], qf[s], p1); } \
        } else {                                                                        \
            if (VAR == 3) { p0 = cinit; p1 = cinit; _Pragma("unroll") for (int s = 0; s < 8; ++s) p0[s] += __builtin_bit_cast(float, (int)kf[s][0]); } else { \
            p0 = mfma32(kf[0], qf[0], cinit); p1 = mfma32(kf[1], qf[0], cinit); \
            _Pragma("unroll") for (int s = 1; s < 4; ++s) { p0 = mfma32(kf[2 * s], qf[s], p0); p1 = mfma32(kf[2 * s + 1], qf[s], p1); } } } \
        __builtin_amdgcn_sched_barrier(0); } while (0)
#define AT_VPRE(t) do { unsigned stv = AT_ST(t); asm volatile("" : "+v"(stv)); vaa = stv + ((VAR == 9) ? (16384u + (unsigned)lane * 8u) : va0); vba = stv + ((VAR == 9) ? (16384u + 2048u + (unsigned)lane * 8u) : vb0); _Pragma("unroll") for (int i_ = 0; i_ < AT_VD; ++i_) AT_VRD(i_); __builtin_amdgcn_sched_barrier(0); } while (0)
#define AT_SM() do { float ps = 0.f; \
        _Pragma("unroll") for (int r = 0; r < 16; ++r) { if (VAR != 1) { p0[r] = __builtin_amdgcn_exp2f(p0[r]); p1[r] = __builtin_amdgcn_exp2f(p1[r]); } ps += p0[r]; ps += p1[r]; }     \
        lsum += ps; \
        _Pragma("unroll") for (int s = 0; s < 4; ++s) { v4u t_; \
            if (s < 2) { t_.x = pkb(p0[8 * s + 0], p0[8 * s + 1]); t_.y = pkb(p0[8 * s + 2], p0[8 * s + 3]); t_.z = pkb(p0[8 * s + 4], p0[8 * s + 5]); t_.w = pkb(p0[8 * s + 6], p0[8 * s + 7]); } \
            else { const int s2 = s - 2; t_.x = pkb(p1[8 * s2 + 0], p1[8 * s2 + 1]); t_.y = pkb(p1[8 * s2 + 2], p1[8 * s2 + 3]); t_.z = pkb(p1[8 * s2 + 4], p1[8 * s2 + 5]); t_.w = pkb(p1[8 * s2 + 6], p1[8 * s2 + 7]); } \
            pf[s] = __builtin_bit_cast(bf16x8, t_); } \
        __builtin_amdgcn_sched_barrier(0); } while (0)
#define AT_PV(t) AT_PV_(t, true)
#define AT_PV_(t, KPF) do { AT_KADDR((t) + 1); _Pragma("unroll") for (int i = 0; i < 16; ++i) { if (i + AT_VD < 16) AT_VRD(i + AT_VD); \
            if ((KPF) && (i & 1) == 0) kf[i >> 1] = AT_KRD((i >> 2), ((i >> 1) & 1)); \
            const bf16x8 vf = (bf16x8){vl[i][0], vl[i][1], vl[i][2], vl[i][3], vh[i][0], vh[i][1], vh[i][2], vh[i][3]}; \
            o[i & 3] = mfma32(vf, pf[i >> 2], o[i & 3]); __builtin_amdgcn_sched_barrier(0); } } while (0)
#define AT_KLOAD(t) do { AT_KADDR(t); _Pragma("unroll") for (int s = 0; s < 4; ++s) { kf[2 * s] = AT_KRD(s, 0); kf[2 * s + 1] = AT_KRD(s, 1); } } while (0)
#define AT_TILE0() do { float tm = fmaxf(p0[0], p1[0]); \
        _Pragma("unroll") for (int r = 1; r < 16; ++r) tm = fmaxf(tm, fmaxf(p0[r], p1[r])); \
        tm = fmaxf(tm, __shfl_xor(tm, 32)); m = tm; \
        _Pragma("unroll") for (int r = 0; r < 16; ++r) { p0[r] -= tm; p1[r] -= tm; } } while (0)
#if AT_PIPE
    unsigned vaa, vba; int j = 0; f32x16 a0, a1, b0, b1; unsigned pw[16]; float mref = 0.f;
#define AT_PIN(x) asm volatile("" : "+v"(x))
#define AT_SBAR() __builtin_amdgcn_sched_barrier(0)
#define AT_SYNCP(t) do { if ((t) + 1 < nt) AT_WAITBAR(4); else AT_WAITBAR(0); if ((t) + 2 < nt) AT_DMA((t) + 2, AT_ST((t) + 2)); } while (0)
#define AT_EL(X, i) (((i) < 16) ? X##0[(i) & 15] : X##1[(i) & 15])
#define AT_EXP2(X, i) do { if ((i) < 16) X##0[(i) & 15] = __builtin_amdgcn_exp2f(X##0[(i) & 15] - mref); else X##1[(i) & 15] = __builtin_amdgcn_exp2f(X##1[(i) & 15] - mref); } while (0)
#define AT_PHASEA(C, P, t, FILL) do { \
        AT_KADDR(t); bf16x8 kq[8]; \
        _Pragma("unroll") for (int g = 0; g < 4; ++g) kq[g] = AT_KRD((g >> 1), (g & 1)); \
        const bool near_ = (t) >= nt - 4; \
        mref = near_ ? m : m - cfar;                                                    \
        if (near_) { const LAS float* lp = lut + ((qw + r32) - (64 * (t) + 4 * hi) + 68); \
            _Pragma("unroll") for (int r = 0; r < 16; ++r) { C##0[r] = lp[59 - ((r & 3) + 8 * (r >> 2))]; C##1[r] = lp[27 - ((r & 3) + 8 * (r >> 2))]; } } \
        else { _Pragma("unroll") for (int r = 0; r < 16; ++r) { C##0[r] = 0.f; C##1[r] = 0.f; } }     \
        float sacc = 0.f; \
        _Pragma("unroll") for (int g = 0; g < 8; ++g) { if (g + 4 < 8) kq[g + 4] = AT_KRD(((g + 4) >> 1), ((g + 4) & 1)); \
            if ((g & 1) == 0) C##0 = mfma32(kq[g], qf[g >> 1], C##0); else C##1 = mfma32(kq[g], qf[g >> 1], C##1); \
            if (FILL) { sacc += AT_EL(P, 4 * g); sacc += AT_EL(P, 4 * g + 1); sacc += AT_EL(P, 4 * g + 2); sacc += AT_EL(P, 4 * g + 3); AT_PIN(sacc); \
                pw[2 * g] = pkb(AT_EL(P, 4 * g), AT_EL(P, 4 * g + 1)); pw[2 * g + 1] = pkb(AT_EL(P, 4 * g + 2), AT_EL(P, 4 * g + 3)); AT_PIN(pw[2 * g]); AT_PIN(pw[2 * g + 1]); } \
            AT_SBAR(); } \
        if (FILL) lsum += sacc; } while (0)
#define AT_PHASEB(C, FILL) do { \
        _Pragma("unroll") for (int i = 0; i < 16; ++i) { if (i + 3 < 16) AT_VRD(i + 3); \
            const bf16x8 vf = (bf16x8){vl[i][0], vl[i][1], vl[i][2], vl[i][3], vh[i][0], vh[i][1], vh[i][2], vh[i][3]}; \
            const v4u pq = {pw[4 * (i >> 2)], pw[4 * (i >> 2) + 1], pw[4 * (i >> 2) + 2], pw[4 * (i >> 2) + 3]}; \
            o[i & 3] = mfma32(vf, __builtin_bit_cast(bf16x8, pq), o[i & 3]); \
            if (FILL) { AT_EXP2(C, 2 * i); AT_EXP2(C, 2 * i + 1); if (i < 8) AT_PIN(C##0); else AT_PIN(C##1); } \
            AT_SBAR(); } } while (0)
    AT_WAITBAR(4);
    AT_SYNCP(0);
    AT_PHASEA(b, a, 0, false);
    { float tm = fmaxf(b0[0], b1[0]);
#pragma unroll
      for (int r = 1; r < 16; ++r) tm = fmaxf(tm, fmaxf(b0[r], b1[r]));
      tm = fmaxf(tm, __shfl_xor(tm, 32)); m = (nt > 4) ? tm + cfar : tm;
#pragma unroll
      for (int r = 0; r < 16; ++r) { b0[r] = __builtin_amdgcn_exp2f(b0[r] - tm); b1[r] = __builtin_amdgcn_exp2f(b1[r] - tm); } }
#define AT_STEP(C, P, t) do { AT_VPRE((t) - 1); AT_SYNCP(t); AT_PHASEA(C, P, t, true); AT_PHASEB(C, true); } while (0)
#pragma unroll 1
    for (j = 1; j + 1 < nt; j += 2) { AT_STEP(a, b, j); AT_STEP(b, a, j + 1); }
    AT_STEP(a, b, nt - 1);
    { float sacc = 0.f;
#pragma unroll
      for (int r = 0; r < 16; ++r) { sacc += a0[r]; sacc += a1[r]; }
      lsum += sacc;
#pragma unroll
      for (int w2 = 0; w2 < 16; ++w2) pw[w2] = pkb(AT_EL(a, 2 * w2), AT_EL(a, 2 * w2 + 1));
      AT_VPRE(nt - 1); AT_PHASEB(a, false); }
#undef AT_PIN
#undef AT_SBAR
#undef AT_SYNCP
#undef AT_EL
#undef AT_EXP2
#undef AT_PHASEA
#undef AT_PHASEB
#undef AT_STEP
#else
    unsigned vaa, vba; int j = 0;
    if (w >= 4) __builtin_amdgcn_s_setprio(1);
    AT_WAITBAR(4);
    { AT_KADDR(0);
#pragma unroll
      for (int s = 0; s < 4; ++s) { kf[2 * s] = AT_KRD(s, 0); kf[2 * s + 1] = AT_KRD(s, 1); } }
    if (map == 0 || !AT_STAGGER) {
        AT_SYNC(); AT_QK(0); AT_VPRE(0); AT_TILE0(); AT_SM(); AT_PV_(0, !AT_STAGGER);
        { const float cm = cfar - m;
#pragma unroll
          for (int r = 0; r < 16; ++r) cinit[r] = cm; }
#pragma unroll 1
        for (j = 1; j < ((VAR == 11) ? 1 : nt); ++j) { AT_SYNC(); if (VAR == 5 || VAR == 10) continue; if (AT_STAGGER) AT_KLOAD(j); AT_QK(j); if (VAR == 2) { AT_SM(); asm volatile("" :: "v"(pf[0]), "v"(pf[1]), "v"(pf[2]), "v"(pf[3])); AT_KLOAD(j + 1); continue; } if (VAR == 6) { asm volatile("" :: "v"(p0), "v"(p1)); AT_KLOAD(j + 1); continue; } AT_VPRE(j); AT_SM(); AT_PV_(j, !AT_STAGGER); }
    } else {
        AT_SYNC(); AT_QK(0); AT_TILE0(); AT_SM();
        { const float cm = cfar - m;
#pragma unroll
          for (int r = 0; r < 16; ++r) cinit[r] = cm; }
#pragma unroll 1
        for (j = 1; j < nt; ++j) { AT_VPRE(j - 1); AT_SYNC(); AT_PV(j - 1); AT_QK(j); AT_SM(); }
        AT_VPRE(nt - 1); AT_PV(nt - 1);
    }
#endif
#undef AT_ST
#undef AT_KRD
#undef AT_VRD
#undef AT_SYNC
#undef AT_KADDR
#undef AT_QK
#undef AT_VPRE
#undef AT_SM
#undef AT_PV
#undef AT_PV_
#undef AT_KLOAD
#undef AT_TILE0
#undef AT_DMA
    AT_WAITBAR(0);
    __builtin_amdgcn_s_setprio(0);
    if (nbh >= 0) {
        const char* nsrc = (const char*)(F.ws + WS_KVH) + ((size_t)(nbh * 128) << 15) + w * 1024 + lane * 16;
        const unsigned d0_ = (unsigned)__builtin_amdgcn_readfirstlane(dma_base), d1_ = (unsigned)__builtin_amdgcn_readfirstlane(dma_base + AT_STAGE);
        glds16(nsrc, d0_); glds16(nsrc + 8192, d0_ + 8192u); glds16(nsrc + 16384, d0_ + 16384u); glds16(nsrc + 24576, d0_ + 24576u);
        glds16(nsrc + 32768, d1_); glds16(nsrc + 32768 + 8192, d1_ + 8192u); glds16(nsrc + 32768 + 16384, d1_ + 16384u); glds16(nsrc + 32768 + 24576, d1_ + 24576u); }
    lsum += __shfl_xor(lsum, 32);
    const float inv = 1.0f / lsum;
    LAS float* EX = (LAS float*)(lds + AT_EX_OFF) + rg * 4096;
    if (map == 1) { const float lv = ((const float*)(F.ws + MS_LAM))[l] * inv;
#pragma unroll
        for (int d = 0; d < 4; ++d)
#pragma unroll
            for (int r = 0; r < 16; ++r) EX[(d * 16 + r) * 64 + lane] = o[d][r] * lv; }
    __syncthreads();
    if (map == 0) { float ss = 0.f;
#pragma unroll
        for (int d = 0; d < 4; ++d) {
#pragma unroll
            for (int r = 0; r < 16; ++r) { const float v = o[d][r] * inv - EX[(d * 16 + r) * 64 + lane]; o[d][r] = v; ss += v * v; }
            __builtin_amdgcn_sched_barrier(0); }
        ss += __shfl_xor(ss, 32);
        const float rn = __builtin_amdgcn_rsqf(ss * (1.0f / 128.0f) + RMS_EPS) * ((const float*)(F.ws + MS_LAM))[2 + l];
        const float* sg = A.in[IN_SUBLN] + l * 128;
        LAS unsigned char* OT = (LAS unsigned char*)EX;
        LDS_WAIT(); asm volatile("" ::: "memory");
#pragma unroll
        for (int d = 0; d < 4; ++d) {
#pragma unroll
            for (int g4 = 0; g4 < 4; ++g4) { const int dd = 32 * d + 8 * g4 + 4 * hi; const f32x4 gg = *(const GAS f32x4*)(sg + dd);
                u32x2g ov; ov.x = pkb(o[d][4 * g4 + 0] * rn * gg.x, o[d][4 * g4 + 1] * rn * gg.y); ov.y = pkb(o[d][4 * g4 + 2] * rn * gg.z, o[d][4 * g4 + 3] * rn * gg.w);
                *(LAS u32x2g*)(OT + r32 * 272 + dd * 2) = ov; }
            __builtin_amdgcn_sched_barrier(0); }
        LDS_WAIT(); asm volatile("" ::: "memory");
        bf16* MXw = (bf16*)(F.ws + WS_MIX) + ((size_t)b * SEQ + qw) * DM + h * 128;
#pragma unroll
        for (int it = 0; it < 8; ++it) { const int row = it * 4 + (lane >> 4), ch = lane & 15; const v4u v = *(const LAS v4u*)(OT + row * 272 + ch * 16); *(GAS v4u*)(MXw + (size_t)row * DM + ch * 8) = v; } }
    __syncthreads();
}

constexpr int RT_LG_STRIDE = 37;
constexpr int RT_PX_OFF = 19456, RT_CNT_OFF = RT_PX_OFF + 4 * 24 * 64 * 4, RT_W_OFF = RT_CNT_OFF + 512, RT_W_STRIDE = 2064, RT_W_ROWS = 40;
static_assert(4 * 32 * RT_LG_STRIDE * 4 <= RT_PX_OFF && RT_W_OFF + RT_W_ROWS * RT_W_STRIDE <= RING_BYTES, "route LDS");
template <bool DRY> __device__ __forceinline__ void route_unit(Frame& F, const ArgsV& A, int l, int u) {
    UNIT_IDS;
    const int r32 = lane & 31, hi = lane >> 5, rgp = wave & 3, kh = wave >> 2, t0 = u * 128 + rgp * 32;
    LAS float* Lg = (LAS float*)(F.lds) + rgp * 32 * RT_LG_STRIDE; LAS int* cnt = (LAS int*)(F.lds + RT_CNT_OFF); LAS float* PX = (LAS float*)(F.lds + RT_PX_OFF) + rgp * (24 * 64);
    if (tid < 32) cnt[tid] = 0;
    const bf16* xp = (const bf16*)(F.ws + WS_XB) + (size_t)(t0 + r32) * DM + hi * 8 + kh * 512;
    v4u xw[32];
#pragma unroll
    for (int s = 0; s < 32; ++s) xw[s] = *(const GAS v4u*)(xp + 16 * s);
    { const char* wsrc = (const char*)(F.ws + WS_WRT) + (size_t)l * 64 * DM * 2 + lane * 16; const unsigned wl = (unsigned)(uintptr_t)(F.lds + RT_W_OFF);
#pragma unroll
      for (int i = 0; i < 10; ++i) { const int pc = wave * 10 + i, row = pc >> 1, hf = pc & 1; glds16(wsrc + row * 2048 + hf * 1024, (unsigned)__builtin_amdgcn_readfirstlane(wl + row * RT_W_STRIDE + hf * 1024)); } }
    float eb[16], gbv[4];
#pragma unroll
    for (int r = 0; r < 16; ++r) eb[r] = A.in[IN_ERB][l * 32 + (r & 3) + 8 * (r >> 2) + 4 * hi];
#pragma unroll
    for (int r = 0; r < 4; ++r) gbv[r] = A.in[IN_GRB][l * 4 + r];
    f32x16 a0, a1; float ss = 0.f;
#pragma unroll
    for (int r = 0; r < 16; ++r) { a0[r] = 0.f; a1[r] = 0.f; }
    asm volatile("s_waitcnt vmcnt(0)" ::: "memory");
    __syncthreads();
    const LAS unsigned char* wa_p = F.lds + RT_W_OFF + r32 * RT_W_STRIDE + kh * 1024 + hi * 16; const LAS unsigned char* wb_p = F.lds + RT_W_OFF + (32 + (r32 & 7)) * RT_W_STRIDE + kh * 1024 + hi * 16;
#pragma unroll
    for (int s = 0; s < 32; ++s) { const bf16x8 wa = *(const LAS bf16x8*)(wa_p + 32 * s), wb = *(const LAS bf16x8*)(wb_p + 32 * s);
        const bf16x8 xb = __builtin_bit_cast(bf16x8, xw[s]);
        a0 = mfma32(wa, xb, a0); a1 = mfma32(wb, xb, a1);
        ss += bflo(xw[s].x) * bflo(xw[s].x) + bfhi(xw[s].x) * bfhi(xw[s].x) + bflo(xw[s].y) * bflo(xw[s].y) + bfhi(xw[s].y) * bfhi(xw[s].y) + bflo(xw[s].z) * bflo(xw[s].z) + bfhi(xw[s].z) * bfhi(xw[s].z) + bflo(xw[s].w) * bflo(xw[s].w) + bfhi(xw[s].w) * bfhi(xw[s].w); }
    if (kh == 1) {
#pragma unroll
        for (int r = 0; r < 16; ++r) PX[r * 64 + lane] = a0[r];
#pragma unroll
        for (int r = 0; r < 4; ++r) PX[(16 + r) * 64 + lane] = a1[r];
        PX[20 * 64 + lane] = ss; }
    __syncthreads();
    if (kh == 0) {
#pragma unroll
    for (int r = 0; r < 16; ++r) a0[r] += PX[r * 64 + lane];
#pragma unroll
    for (int r = 0; r < 4; ++r) a1[r] += PX[(16 + r) * 64 + lane];
    ss += PX[20 * 64 + lane];
    ss += __shfl_xor(ss, 32);
    const float rs = __builtin_amdgcn_rsqf(ss * (1.0f / 1024.0f) + RMS_EPS);
#pragma unroll
    for (int r = 0; r < 16; ++r) { const int n = (r & 3) + 8 * (r >> 2) + 4 * hi; Lg[r32 * RT_LG_STRIDE + n] = a0[r] * rs + eb[r]; }
    if (hi == 0) {
#pragma unroll
        for (int r = 0; r < 4; ++r) Lg[r32 * RT_LG_STRIDE + 32 + r] = a1[r] * rs + gbv[r]; }
    LDS_WAIT(); asm volatile("" ::: "memory");
    if (lane < 32) { const LAS float* L = Lg + lane * RT_LG_STRIDE; const int t = t0 + lane;
        int gi = 0; float gm = L[32];
#pragma unroll
        for (int k = 1; k < 4; ++k) { const float v = L[32 + k]; if (v > gm) { gm = v; gi = k; } }
        float gs = 0.f;
#pragma unroll
        for (int k = 0; k < 4; ++k) gs += __expf(L[32 + k] - gm);
        const float gp = 1.0f / gs;
        int i1 = 0; float v1 = L[gi * 8];
#pragma unroll
        for (int k = 1; k < 8; ++k) { const float v = L[gi * 8 + k]; if (v > v1) { v1 = v; i1 = k; } }
        int i2 = -1; float v2 = -3.0e38f;
#pragma unroll
        for (int k = 0; k < 8; ++k) { const float v = L[gi * 8 + k]; if (k != i1 && v > v2) { v2 = v; i2 = k; } }
        const float e2 = __expf(v2 - v1), w1 = 1.0f / (1.0f + e2), w2 = e2 * w1;
        const int e1x = gi * 8 + i1, e2x = gi * 8 + i2;
        ((int*)(F.ws + MS_TOKE))[2 * t] = e1x; ((int*)(F.ws + MS_TOKE))[2 * t + 1] = e2x;
        ((float*)(F.ws + MS_TOKW))[2 * t] = gp * w1; ((float*)(F.ws + MS_TOKW))[2 * t + 1] = gp * w2;
        ((float*)(F.ws + MS_RS2))[t] = rs;
        atomicAdd((int*)&cnt[e1x], 1); atomicAdd((int*)&cnt[e2x], 1); }
    }
    __syncthreads();
    if (!DRY && tid < 32) { const int c = cnt[tid]; if (c) atomicAdd((unsigned*)(F.ctl + CW_CNT + l * 32 + tid), (unsigned)c); }
    __syncthreads();
}
__device__ __forceinline__ void slots_unit(Frame& F, int l, int u, int curw) {
    LAS int* pstart = (LAS int*)(F.lds); LAS int* lcnt = pstart + 32; LAS int* lbase = pstart + 64; LAS int* slots = pstart + 128;
    UNIT_IDS;
    const int t = u * 256 + (tid >> 1), k = tid & 1;
    const int e = ((const int*)(F.ws + MS_TOKE))[2 * t + k]; const float rs2v = ((const float*)(F.ws + MS_RS2))[t], tkw = ((const float*)(F.ws + MS_TOKW))[2 * t + k];
    if (wave == 0) {
        const int c = lane < 32 ? (int)__hip_atomic_load(F.ctl + CW_CNT + l * 32 + (lane & 31), RLX_AGENT) : 0; const int padded = ((c + MOEB - 1) / MOEB) * MOEB;
        int incl = padded;
#pragma unroll
        for (int o = 1; o < 32; o <<= 1) { const int v = __shfl_up(incl, o); if (lane >= o) incl += v; }
        if (lane < 32) { pstart[lane] = incl - padded; lcnt[lane] = 0;
            if (u == 0) { const int k = padded / MOEB, nb0 = (incl - padded) / MOEB;
                for (int i = 0; i < k; ++i) ((GAS int*)(F.ctl + CW_BLKE + l * NSLOTB))[nb0 + i] = lane;
                if (lane == 31) *((GAS int*)(F.ctl + CW_NUSED + l)) = incl / MOEB; } } }
    __syncthreads();
    const int rank = atomicAdd((int*)&lcnt[e], 1);
    __syncthreads();
    if (tid < 32) { const int c = lcnt[tid]; lbase[tid] = pstart[tid] + (c ? (int)atomicAdd((unsigned*)(F.ctl + curw + tid), (unsigned)c) : 0); }
    __syncthreads();
    const int slot = lbase[e] + rank;
    slots[tid] = slot;
    ((int*)(F.ws + MS_SLOT))[2 * t + k] = slot;
    ((float*)(F.ws + MS_RSSLOT))[slot] = rs2v;
    ((float*)(F.ws + MS_WSLOT))[slot] = tkw;
    ((int*)(F.ws + MS_TOKSLOT))[slot] = t;
    if (u == 0) { for (int e = tid >> 4; e < NE; e += 32) { const int c = (int)__hip_atomic_load(F.ctl + CW_CNT + l * 32 + e, RLX_AGENT), pad = ((c + MOEB - 1) / MOEB) * MOEB;
            for (int i = c + (tid & 15); i < pad; i += 16) ((int*)(F.ws + MS_TOKSLOT))[pstart[e] + i] = 0; } }
    __syncthreads();
}
template <bool DRY> __device__ __forceinline__ void combine_rows(Frame& F, const ArgsV& A, bool last) {
    const int gw = F.vcu * 8 + F.wave, NGW = F.G * 8, lane = F.lane;
    const bf16* Y = (const bf16*)(F.ws + WS_Y);
    const int ntk = (NTOK - gw + NGW - 1) / NGW;
    int sl0 = 0, sl1 = 0; if (lane < ntk) { const int t = gw + lane * NGW; sl0 = ((const int*)(F.ws + MS_SLOT))[2 * t]; sl1 = ((const int*)(F.ws + MS_SLOT))[2 * t + 1]; }
#pragma unroll 1
    for (int i0 = 0; i0 < ntk; i0 += 4) {
        u32x2g xv[4][4], av[4][4], bv[4][4];
#pragma unroll
        for (int q = 0; q < 4; ++q) { const int i = (i0 + q < ntk) ? i0 + q : ntk - 1; const int t = gw + i * NGW;
            const int s0 = (i < 64) ? __builtin_amdgcn_readlane(sl0, i & 63) : ((const int*)(F.ws + MS_SLOT))[2 * t], s1 = (i < 64) ? __builtin_amdgcn_readlane(sl1, i & 63) : ((const int*)(F.ws + MS_SLOT))[2 * t + 1];
            const GAS u32x2g* xb = (const GAS u32x2g*)((const bf16*)(F.ws + WS_XB) + (size_t)t * DM) + lane;
            const GAS u32x2g* y0 = (const GAS u32x2g*)(Y + (size_t)s0 * DM) + lane; const GAS u32x2g* y1 = (const GAS u32x2g*)(Y + (size_t)s1 * DM) + lane;
#pragma unroll
            for (int j = 0; j < 4; ++j) { xv[q][j] = xb[64 * j]; av[q][j] = y0[64 * j]; bv[q][j] = y1[64 * j]; } }
#pragma unroll
        for (int q = 0; q < 4; ++q) if (i0 + q < ntk) { const int t = gw + (i0 + q) * NGW;
            GAS u32x2g* xb = (GAS u32x2g*)((bf16*)(F.ws + WS_XB) + (size_t)t * DM) + lane;
            f32x4 v[4]; float s = 0.f;
#pragma unroll
            for (int j = 0; j < 4; ++j) { const u32x2g x = xv[q][j], a = av[q][j], b = bv[q][j];
                v[j] = (f32x4){bflo(x.x) + bflo(a.x) + bflo(b.x), bfhi(x.x) + bfhi(a.x) + bfhi(b.x), bflo(x.y) + bflo(a.y) + bflo(b.y), bfhi(x.y) + bfhi(a.y) + bfhi(b.y)};
                s += (v[j].x * v[j].x + v[j].y * v[j].y) + (v[j].z * v[j].z + v[j].w * v[j].w); }
            s = wave_sum(s);
            if (DRY) { if (s == 123.456f) ((float*)(F.ws + MS_ROWSS))[t] = s; }
            else if (!last) {
#pragma unroll
                for (int j = 0; j < 4; ++j) { u32x2g o; o.x = pkb(v[j].x, v[j].y); o.y = pkb(v[j].z, v[j].w); xb[64 * j] = o; }
                if (lane == 0) ((float*)(F.ws + MS_ROWSS))[t] = s;
            } else { const float rs = __builtin_amdgcn_rsqf(s * (1.0f / 1024.0f) + RMS_EPS); const GAS f32x4* fg = (const GAS f32x4*)A.in[IN_FING] + lane;
                GAS f32x4* xr = (GAS f32x4*)(F.out + (size_t)t * DM) + lane;
#pragma unroll
                for (int j = 0; j < 4; ++j) xr[64 * j] = v[j] * rs * fg[64 * j]; } }
    }
}
constexpr int PH_PER_LAYER = 9, N_PHASES = 1 + DEPTH * PH_PER_LAYER;
#ifndef MK_ONE_LAUNCH
#define MK_ONE_LAUNCH 1
#endif
#ifndef MK_CG_SYNC
#define MK_CG_SYNC 0
#endif
__global__ void __launch_bounds__(512, 2) hymba_fwd(Args args) {
    extern __shared__ __attribute__((aligned(16))) unsigned char lds_raw[];
    Frame F;
    F.lds = (LAS unsigned char*)lds_raw;
    F.MISC = (volatile LAS unsigned*)(F.lds + MISC_OFF);
    F.tid = threadIdx.x; F.lane = F.tid & 63; F.wave = __builtin_amdgcn_readfirstlane(F.tid >> 6);
    F.G = gridDim.x; { const int bx = blockIdx.x; F.vcu = (F.G % 8 == 0) ? (bx % 8) * (F.G / 8) + bx / 8 : bx; }
    F.ws = args.ws; F.out = args.out; F.ctl = (gu32*)(args.ws + WS_CTL);
    for (int u = F.tid; u < (LDS_BYTES - LDSCTL_OFF) / 4; u += 512) ((LAS unsigned*)(F.lds + LDSCTL_OFF))[u] = 0u;
    __syncthreads();
    const int lo = args.ph_lo, hi = args.ph_hi;
    const bool fused = (hi - lo) > 1;
    XcdBarrier bar; bar.bar = (unsigned*)(F.ctl + CW_BAR); bar.x = 0; bar.st = nullptr;
    if (fused) bar = xcd_barrier_post((unsigned*)(F.ctl + CW_BAR), F.MISC + 8);
    if (threadIdx.x == 0) __hip_atomic_store(F.ctl + CW_XCC + F.vcu, xb_xcc_id() + 1u, RLX_AGENT);
#ifndef ONLY_T
#define ONLY_T -1
#endif
#define PH_EN(t) (ONLY_T < 0 || ONLY_T == (t))
#ifndef DUP_T
#define DUP_T -1
#endif
#ifndef PROBE_VAR
#define PROBE_VAR 0
#endif
#define REP(t) for (int rep_ = 0; rep_ < ((DUP_T == (t) && l == 0) ? 2 : 1); ++rep_)
#define IN(k) (lo <= (k) && (k) < hi)
#define REFRESH() do { int t_ = threadIdx.x; asm volatile("" : "+v"(t_)); F.tid = t_; F.lane = t_ & 63; F.wave = __builtin_amdgcn_readfirstlane(t_ >> 6); asm volatile("" : "+s"(F.ws), "+s"(F.out), "+s"(F.ctl)); } while (0)
#define SEAM(k) do { if (IN(k) && IN((k) + 1)) { xcd_barrier(bar); if (DUP_T == 10) xcd_barrier(bar); } } while (0)
    for (int rep0_ = 0; rep0_ < (DUP_T == 0 ? 2 : 1); ++rep0_) if (PH_EN(0) && IN(0)) { REFRESH(); p0_prologue(F, args_view()); }
#if MK_CG_SYNC
    if (fused && IN(0)) { cg::this_grid().sync(); }
    else SEAM(0);
#else
    SEAM(0);
#endif
#pragma unroll 1
    for (int l = 0; l < DEPTH; ++l) {
        const int pb = 1 + l * PH_PER_LAYER;
        REP(1) if (PH_EN(1) && IN(pb + 0)) { REFRESH(); unsigned char* ws = F.ws;
            pg8::Gemm g{(const pg8::bf16_t*)(ws + WS_XB), (const pg8::bf16_t*)(ws + WS_WIN) + (size_t)l * NCOL * DM, NTOK, NCOL, DM, 0, nullptr, (const float*)(ws + MS_ROWSS), (unsigned)(uintptr_t)(F.lds + SCAL_OFF)};
            pg8::StaticOrder S; S.init(NTOK, NCOL, F.G, (int)blockIdx.x);
            pg8::EpiProj E{(pg8::bf16_t*)(ws + WS_PROJ), (pg8::bf16_t*)(ws + WS_KVH), (const LAS float*)(F.lds + SCAL_OFF)};
            pg8::gemm_phase<pg8::EpiProj, pg8::StaticOrder, true, true>(F.lds + RING_OFF, g, S, E);
            if (F.G == 256 && (int)blockIdx.x >= 128) { pg8::Unit uu; int pm6 = -1;
                for (int i = 0; i < 4; ++i) if (S.next(i, uu) && uu.pn == 6) pm6 = uu.pm;
                if (pm6 >= 0) { const int u0 = (pm6 >> 5) * SSM_NRUN + (pm6 & 31) * 2; ssmA_unit(F, l, u0); ssmA_unit(F, l, u0 + 1); } }
        }
        SEAM(pb + 0);
        REP(2) if (PH_EN(2) && IN(pb + 1) && F.G != 256) { REFRESH();
            for (int u = F.vcu; u < NB * SSM_NRUN; u += F.G) ssmA_unit(F, l, u);
            const ArgsV av = args_view();
            for (int u = F.vcu; u < NB * 128; u += F.G) conv_unit(F, av, l, u);
        }
        if (F.G != 256) SEAM(pb + 1);
        REP(3) if (PH_EN(3) && IN(pb + 2)) { REFRESH(); const ArgsV av = args_view();
#ifndef PROBE_VAR
#define PROBE_VAR 0
#endif
            const bool probe_pass = (DUP_T == 3 && PROBE_VAR != 0 && l == 0 && rep_ == 0);
            if (F.G == 256 && !probe_pass) for (int u = F.vcu; u < NB * 128; u += F.G) conv_unit(F, av, l, u);
            if (!probe_pass || PROBE_VAR == 8) for (int u = F.vcu; u < NB * SSM_NRUN; u += F.G) ssmC_unit(F, av, l, u);
#ifndef NO_ATTN
            if (probe_pass && PROBE_VAR == 8) {} else {
                const bool bal = (F.G == 256); const int xg = F.vcu >> 5, s = F.vcu & 31; const int nu = bal ? 4 : (1024 - F.vcu + F.G - 1) / F.G;
#pragma unroll 1
                for (int i = 0; i < nu; ++i) { int bh, qi, nbh; bool pre;
                    if (bal) { bh = 2 * xg + (i >> 1); qi = (i & 1) ? 63 - s : s; nbh = (i < 3) ? 2 * xg + ((i + 1) >> 1) : -1; pre = i > 0; }
                    else { const int u = F.vcu + i * F.G; bh = u >> 6; qi = 63 - (u & 63); nbh = -1; pre = false; }
#if PROBE_VAR != 0 && PROBE_VAR != 8
                    if (probe_pass) { attn_unit<PROBE_VAR>(F, av, l, bh >> 2, bh & 3, qi, pre, nbh); continue; }
#endif
                    attn_unit<0>(F, av, l, bh >> 2, bh & 3, qi, pre, nbh); } }
#endif
        }
        SEAM(pb + 2);
        REP(4) if (PH_EN(4) && IN(pb + 3)) { REFRESH(); unsigned char* ws = F.ws;
            pg8::Gemm g{(const pg8::bf16_t*)(ws + WS_MIX), (const pg8::bf16_t*)(ws + WS_WOUT) + (size_t)l * DM * DM, NTOK, DM, DM, 0, nullptr, nullptr, 0u};
            pg8::StaticOrder S; S.init(NTOK, DM, F.G, (int)blockIdx.x);
            pg8::EpiResid E{(pg8::bf16_t*)(ws + WS_XB), (DUP_T == 4 && l == 0 && rep_ == 0) ? (pg8::bf16_t*)(ws + WS_KVH) : (pg8::bf16_t*)(ws + WS_XB)};
            pg8::gemm_phase<pg8::EpiResid, pg8::StaticOrder, true, true>(F.lds + RING_OFF, g, S, E);
            if (F.G == 256 && DUP_T != 4) { pg8::Unit u0, u1; (void)S.next(0, u0); (void)S.next(1, u1); const int bx = (int)blockIdx.x, pnm = bx >> 6, pmr = (pnm < 2) ? u0.pm : u1.pm;
                if (threadIdx.x == 0) { gu32* xt = F.ctl + CW_XCC; gu32* rt = F.ctl + CW_RT + l * 128; const unsigned myx = xb_xcc_id(); bool homo = true;
#pragma unroll
                    for (int j = 0; j < 4; ++j) { const int b2 = (bx & 63) + 64 * j; homo = homo && (__hip_atomic_load(xt + (b2 % 8) * 32 + b2 / 8, RLX_AGENT) == myx + 1u); }
                    if (!homo) { __builtin_amdgcn_fence(__ATOMIC_RELEASE, "agent"); VM_WAIT(); }
                    (void)__hip_atomic_fetch_add(rt + u0.pm, 1u, RLX_AGENT); (void)__hip_atomic_fetch_add(rt + u1.pm, 1u, RLX_AGENT);
                    pg8::DownOrder::poll_ge(rt + pmr, 4u);
                    __builtin_amdgcn_fence(__ATOMIC_ACQUIRE, "agent"); VM_WAIT(); }
                __syncthreads();
                route_unit<false>(F, args_view(), l, 2 * pmr + (pnm & 1)); }
        }
        if (F.G != 256 || DUP_T == 4) SEAM(pb + 3);
        REP(5) if (PH_EN(5) && IN(pb + 4) && (F.G != 256 || DUP_T == 4)) { REFRESH(); for (int u = F.vcu; u < NTOK / 128; u += F.G) { if (DUP_T == 5 && l == 0 && rep_ == 0) route_unit<true>(F, args_view(), l, u); else route_unit<false>(F, args_view(), l, u); } }
        SEAM(pb + 4);
        REP(6) if (PH_EN(6) && IN(pb + 5)) { REFRESH(); for (int u = F.vcu; u < NTOK / 256; u += F.G) slots_unit(F, l, u, (DUP_T == 6 && l == 0 && rep_ == 0) ? CW_CUR + 1024 : CW_CUR + l * 32);
            convert_items(F, args_view(), 2 * (1152 + 512 + 32) + l * NE * 768, 2 * (1152 + 512 + 32) + (l + 1) * NE * 768); }
        SEAM(pb + 5);
        REP(7) if (PH_EN(7) && IN(pb + 6)) { REFRESH(); unsigned char* ws = F.ws;
            const int n_used = (int)__hip_atomic_load(F.ctl + CW_NUSED + l, RLX_AGENT);
            gu32* qd = F.ctl + CW_GUD + ((DUP_T == 7 && l == 0 && rep_ == 0) ? 2 : l) * 4096;
            { pg8::Gemm g{(const pg8::bf16_t*)(ws + WS_XB), (const pg8::bf16_t*)(ws + WS_WGU) + (size_t)l * NE * 1024 * 1024, PSLOTS, 1024, DM, (size_t)1024 * 1024 * 2, (const int*)(ws + MS_TOKSLOT), (const float*)(ws + MS_RSSLOT), (unsigned)(uintptr_t)(F.lds + SCAL_OFF)};
              pg8::GroupedOrder S; S.init(n_used, 4, F.G, F.vcu, (const int*)(F.ctl + CW_BLKE + l * NSLOTB));
              pg8::EpiGateUp E{(pg8::bf16_t*)(ws + WS_ACT), (const LAS float*)(F.lds + SCAL_OFF)};
              pg8::gemm_phase<pg8::EpiGateUp, pg8::GroupedOrder, true, true, true>(F.lds + RING_OFF, g, S, E); }
            VM_WAIT(); __syncthreads();
            if (F.wave == 0) { const unsigned myx = xb_xcc_id(); const int q = F.vcu >> 2, r_ = (n_used * 4) % F.G; gu32* xt = F.ctl + CW_XCC;
                bool homo = true;
#pragma unroll
                for (int k = 0; k < 4; ++k) homo = homo && (__hip_atomic_load(xt + q * 4 + k, RLX_AGENT) == myx + 1u);
                int na = 0;
                for (int cc = F.lane; cc < r_; cc += 64) na += (__hip_atomic_load(xt + cc, RLX_AGENT) == myx + 1u) ? 1 : 0;
#pragma unroll
                for (int o = 32; o > 0; o >>= 1) na += __shfl_xor(na, o);
                if (F.lane == 0) {
                    if (!homo) { __builtin_amdgcn_fence(__ATOMIC_RELEASE, "agent"); VM_WAIT(); }
                    if (F.vcu < r_) { const unsigned old_ = __hip_atomic_fetch_add(qd + myx * 64 + 16, 1u, RLX_AGENT);
                        if ((int)old_ + 1 == na) { __builtin_amdgcn_fence(__ATOMIC_RELEASE, "agent"); VM_WAIT(); __hip_atomic_store(qd + myx * 64 + 17, 1u, RLX_AGENT); } }
                    (void)__hip_atomic_fetch_add(qd + q * 64, 1u, RLX_AGENT);
                    pg8::DownOrder::poll_ge(qd + q * 64, 4u);
                    __builtin_amdgcn_fence(__ATOMIC_ACQUIRE, "agent"); VM_WAIT(); } }
            __syncthreads();
            { pg8::Gemm g{(const pg8::bf16_t*)(ws + WS_ACT), (const pg8::bf16_t*)(ws + WS_WDN) + (size_t)l * NE * DM * FF, PSLOTS, DM, FF, (size_t)DM * FF * 2, nullptr, (const float*)(ws + MS_WSLOT), (unsigned)(uintptr_t)(F.lds + SCAL_OFF)};
              pg8::DownOrder S; S.init(n_used, F.G, F.vcu, (const int*)(F.ctl + CW_BLKE + l * NSLOTB), qd, F.ctl + CW_XCC);
              pg8::EpiDown E{(pg8::bf16_t*)(ws + WS_Y), (const LAS float*)(F.lds + SCAL_OFF)};
              pg8::gemm_phase<pg8::EpiDown, pg8::DownOrder, true, true>(F.lds + RING_OFF, g, S, E); }
        }
        SEAM(pb + 7);
        REP(9) if (PH_EN(9) && IN(pb + 8)) { REFRESH(); if (DUP_T == 9 && l == 0 && rep_ == 0) combine_rows<true>(F, args_view(), false); else combine_rows<false>(F, args_view(), l == DEPTH - 1); }
        SEAM(pb + 8);
    }
#undef IN
#undef SEAM
}

extern "C" void kernel_launch(void* const* d_in, const int* in_sizes, int n_in, void* d_out, int out_size, void* d_ws, size_t ws_size, hipStream_t stream) {
    static int grid = 0;
    if (grid == 0) {
        if (n_in != N_IN || in_sizes[0] != NTOK * DM || out_size != NTOK * DM || ws_size < WS_END) { fprintf(stderr, "kernel_launch: unexpected shapes (n_in %d, in0 %d, out %d, ws %zu)\n", n_in, n_in > 0 ? in_sizes[0] : -1, out_size, ws_size); grid = -1; return; }
        int dev = 0, cus = 0, per_cu = 0;
        if (hipGetDevice(&dev) != hipSuccess || hipDeviceGetAttribute(&cus, hipDeviceAttributeMultiprocessorCount, dev) != hipSuccess) { grid = -1; return; }
        if (hipFuncSetAttribute((const void*)hymba_fwd, hipFuncAttributeMaxDynamicSharedMemorySize, LDS_BYTES) != hipSuccess) { fprintf(stderr, "kernel_launch: hipFuncSetAttribute failed\n"); grid = -1; return; }
        if (hipOccupancyMaxActiveBlocksPerMultiprocessor(&per_cu, (const void*)hymba_fwd, 512, LDS_BYTES) != hipSuccess || per_cu < 1) { fprintf(stderr, "kernel_launch: occupancy query says %d blocks per CU\n", per_cu); (void)hipGetLastError(); grid = -1; return; }
        grid = cus;
    }
    if (grid < 0) return;
    (void)hipMemsetAsync((char*)d_ws + WS_CTL, 0, CTL_ZERO_BYTES, stream);
    Args a{};
    for (int i = 0; i < N_IN; ++i) a.in[i] = (const float*)d_in[i];
    a.out = (float*)d_out; a.ws = (unsigned char*)d_ws;
#if MK_ONE_LAUNCH
    a.ph_lo = 0; a.ph_hi = N_PHASES;
    void* kargs[] = {&a};
    hipError_t e = hipLaunchCooperativeKernel((const void*)hymba_fwd, dim3(grid), dim3(512), kargs, LDS_BYTES, stream);
    if (e != hipSuccess) fprintf(stderr, "kernel_launch: cooperative launch failed: %s (grid %d)\n", hipGetErrorString(e), grid);
#else
    for (int p = 0; p < N_PHASES; ++p) { a.ph_lo = p; a.ph_hi = p + 1; hipLaunchKernelGGL(hymba_fwd, dim3(grid), dim3(512), LDS_BYTES, stream, a); }
#endif
}
```

```cpp
#include <hip/hip_runtime.h>
#include <hip/hip_cooperative_groups.h>
#include <cstdio>
#include <cstdint>
namespace cg = cooperative_groups;
#define MK_ONE_LAUNCH 1
#define DUP_T -1
#define AT_STAGGER 0
#define AT_PIPE 0

constexpr int DM = 1024, NB = 4, SEQ = 8192, NTOK = NB * SEQ, DEPTH = 2;
constexpr int NCOL = 2304;
constexpr int NCOLP = 1280;
constexpr int COL_Q = 0, COL_CONV = 512, COL_SSM = 1024;
constexpr int NE = 32, FF = 512, MOEB = 256, NSLOTB = 288, PSLOTS = NSLOTB * MOEB;
constexpr int SSM_RUN = 128, SSM_NRUN = SEQ / SSM_RUN;
constexpr float RMS_EPS = 1e-6f, LN_EPS_C = 1e-5f;
constexpr float LOG2E = 1.4426950408889634f;
constexpr float QSCALE = 0.125f * LOG2E;

constexpr size_t MiB = 1u << 20;
constexpr size_t WS_CTL = 0, CTL_ZERO_BYTES = 1 * MiB;
constexpr size_t WS_WIN = 2 * MiB;
constexpr size_t WS_WOUT = 11 * MiB;
constexpr size_t WS_WGLU = 15 * MiB;
constexpr size_t WS_WRT = 16 * MiB;
constexpr size_t WS_WGU = 17 * MiB;
constexpr size_t WS_WDN = 145 * MiB;
constexpr size_t WS_XB = 209 * MiB;
constexpr size_t WS_PROJ = 273 * MiB;
constexpr size_t WS_KVH = WS_PROJ + 80 * MiB;
constexpr size_t WS_MIX = 417 * MiB;
constexpr size_t WS_SSM = 481 * MiB;
constexpr size_t WS_ACT = WS_PROJ;
constexpr size_t WS_Y = WS_PROJ + 72 * MiB;
constexpr size_t WS_MISC = 489 * MiB;
constexpr size_t MS_ROWSS = WS_MISC;
constexpr size_t MS_TOKE = MS_ROWSS + 128 * 1024;
constexpr size_t MS_TOKW = MS_TOKE + 256 * 1024;
constexpr size_t MS_RS2 = MS_TOKW + 256 * 1024;
constexpr size_t MS_SLOT = MS_RS2 + 128 * 1024;
constexpr size_t MS_RSSLOT = MS_SLOT + 256 * 1024;
constexpr size_t MS_WSLOT = MS_RSSLOT + 288 * 1024;
constexpr size_t MS_TOKSLOT = MS_WSLOT + 288 * 1024;
constexpr size_t MS_SSMP = MS_TOKSLOT + 288 * 1024;
constexpr int SP_AR = 0, SP_AI = 1024, SP_ARL = 2048, SP_AIL = 3072, SP_BBR = 4096, SP_BBI = 4096 + 16384, SP_END = 4096 + 32768;
constexpr size_t MS_SSMC = MS_SSMP + 2 * SP_END * 4;
constexpr size_t MS_LUT = MS_SSMC + 2 * 16 * 16 * 128 * 2;
constexpr size_t MS_LAM = MS_LUT + 4 * 132 * 4;
constexpr size_t WS_END = 497 * MiB;
static_assert(MS_LAM + 64 <= WS_END, "misc region");
constexpr int CW_BAR = 4096;
constexpr int CW_CNT = 16384;
constexpr int CW_CUR = 16384 + 64;
constexpr int CW_NUSED = 16384 + 128;
constexpr int CW_BLKE = 16384 + 256;
constexpr int CW_GUD = 16384 + 2048;
constexpr int CW_XCC = CW_GUD + 3 * 4096;
constexpr int CW_RT = CW_XCC + 256;

constexpr int RING_OFF = 0, RING_BYTES = 131072;
constexpr int LDSCTL_OFF = RING_BYTES, MISC_OFF = LDSCTL_OFF + 320;
constexpr int LUT_OFF = MISC_OFF + 128;
constexpr int SCAL_OFF = LUT_OFF + 4096;
constexpr int LDS_BYTES = 147456;
static_assert(LUT_OFF + 520 * 4 <= SCAL_OFF && SCAL_OFF % 16 == 0 && SCAL_OFF + 1024 <= LDS_BYTES, "LDS map");
namespace pg8 {
#define PG8_LAS __attribute__((address_space(3)))
typedef unsigned short bf16_t;
typedef short bf16x8 __attribute__((ext_vector_type(8)));
typedef float f32x4 __attribute__((ext_vector_type(4)));
typedef unsigned u32x4 __attribute__((ext_vector_type(4)));
constexpr int BM = 256, BK = 64, HALF = 128, HTB = HALF * BK * 2  , STAGE_BYTES = 8 * HTB, NXCD = 8, WGM = 8;

__host__ __device__ __forceinline__ int lds_byte(int r, int c) { const int st = (r >> 4) * 2 + (c >> 5), rr = r & 15, cc = c & 31, ob = rr * 64 + cc * 2; return st * 1024 + (ob ^ (((ob >> 9) & 1) << 5)); }
__host__ __device__ __forceinline__ void stage_rc(int b, int& R, int& C) { const int st = b / 1024, sb = b % 1024, swz = sb ^ (((sb >> 9) & 1) << 5); R = (st >> 1) * 16 + swz / 64; C = (st & 1) * 32 + (swz % 64) / 2; }
__host__ __device__ __forceinline__ int perm32(int rho) { const int n = rho >> 4, i = rho & 15; return 8 * (i >> 2) + 4 * n + (i & 3); }

struct Unit { int pm, pn, e; };
struct Gemm { const bf16_t* A; const bf16_t* Bt; int M, N, K; size_t bstride; const int* gat; const float* scal; unsigned scal_lds; };

struct StaticOrder {
    int nM, nN, nwg, G, c;
    __host__ __device__ void init(int M, int N, int G_, int c_) { nM = M / BM; nN = N / BM; nwg = nM * nN; G = G_; c = c_; }
    __host__ __device__ bool next(int i, Unit& u) const {
        const long L = (long)i * G + c; if (L >= nwg) return false;
        int wgid = (int)L; { const int q = nwg / NXCD, r = nwg % NXCD, xcd = wgid % NXCD, off = wgid / NXCD; wgid = (xcd < r ? xcd * (q + 1) : r * (q + 1) + (xcd - r) * q) + off; }
        const int nig = WGM * nN, gid = wgid / nig, fm = gid * WGM, gsz = (nM - fm) < WGM ? (nM - fm) : WGM;
        u.pm = fm + ((wgid % nig) % gsz); u.pn = (wgid % nig) / gsz; u.e = 0; return true;
    }
    __device__ __forceinline__ void a_ready(const Unit&) const {}
    __device__ __forceinline__ void done(const Unit&) const {}
};


#define PG8_GAS __attribute__((address_space(1)))
typedef float f32x2e __attribute__((ext_vector_type(2))); typedef __bf16 bf16x2e __attribute__((ext_vector_type(2))); typedef unsigned u32x2 __attribute__((ext_vector_type(2)));
__device__ __forceinline__ unsigned pk_bf16(float lo, float hi) { f32x2e v = {lo, hi}; bf16x2e b = __builtin_convertvector(v, bf16x2e); return __builtin_bit_cast(unsigned, b); }
__device__ __forceinline__ u32x4 pk8(const f32x4& v0, const f32x4& v1) { u32x4 w; w.x = pk_bf16(v0[0], v0[1]); w.y = pk_bf16(v0[2], v0[3]); w.z = pk_bf16(v1[0], v1[1]); w.w = pk_bf16(v1[2], v1[3]); return w; }

struct EpiProj {
    static constexpr bool PERM = true, AFTER_DRAIN = false;
    bf16_t* O; bf16_t* KVH; const PG8_LAS float* sl;
    __device__ __forceinline__ void operator()(const f32x4 (&acc)[2][2][4][2], const Unit& u, int wr, int wc, int fr, int fq) const {
        const int row0 = u.pm * BM + wr * 64 + fr, cw = wc * 32 + 8 * fq;
        const int pn = u.pn; const float cs = (pn < 2) ? QSCALE : 1.0f;
        const int pcol = (pn < 2) ? pn * 256 : (pn == 6 ? 1024 : (pn - 7) * 256 + 512);
#pragma unroll
        for (int ai = 0; ai < 2; ++ai)
#pragma unroll
            for (int m = 0; m < 4; ++m) { const int row = row0 + ai * HALF + m * 16; const float rs = __builtin_amdgcn_rsqf(sl[row - u.pm * BM] * (1.0f / 1024.0f) + RMS_EPS) * cs;
                const int bb = row >> 13, tl = row & 8191, jt = tl >> 6, kr = tl & 63;
#pragma unroll
                for (int bj = 0; bj < 2; ++bj) { const f32x4 v0 = acc[ai][bj][m][0] * rs, v1 = acc[ai][bj][m][1] * rs; const u32x4 w = pk8(v0, v1); const int c = cw + bj * HALF;
                    if (pn < 2 || pn >= 6) { *(PG8_GAS u32x4*)(O + (size_t)row * NCOLP + pcol + c) = w; }
                    else if (pn < 4) { const int hh = c >> 6, ch = (c & 63) >> 3;
                        char* img = (char*)KVH + ((size_t)((bb * 4 + hh) * 128 + jt) << 15) + (pn - 2) * 8192;
                        *(PG8_GAS u32x4*)(img + kr * 128 + ((ch ^ ((kr >> 1) & 7)) << 4)) = w; }
                    else { const int c5 = (pn - 4) * 256 + c, hh = c5 >> 7, ch = (c5 & 127) >> 3;
                        char* img = (char*)KVH + ((size_t)((bb * 4 + hh) * 128 + jt) << 15) + 16384;
                        *(PG8_GAS u32x4*)(img + kr * 256 + ((ch ^ (((kr & 3) << 2) | ((kr >> 2) & 3))) << 4)) = w; } } }
    }
};
struct EpiResid {
    static constexpr bool PERM = true, AFTER_DRAIN = false;
    bf16_t* XB; bf16_t* XO;
    __device__ __forceinline__ void operator()(const f32x4 (&acc)[2][2][4][2], const Unit& u, int wr, int wc, int fr, int fq) const {
        const int row0 = u.pm * BM + wr * 64 + fr, col0 = u.pn * BM + wc * 32 + 8 * fq;
        u32x4 xr[2][4][2];
#pragma unroll
        for (int ai = 0; ai < 2; ++ai)
#pragma unroll
            for (int m = 0; m < 4; ++m)
#pragma unroll
                for (int bj = 0; bj < 2; ++bj) xr[ai][m][bj] = *(const PG8_GAS u32x4*)(XB + (size_t)(row0 + ai * HALF + m * 16) * DM + col0 + bj * HALF);
#pragma unroll
        for (int ai = 0; ai < 2; ++ai)
#pragma unroll
            for (int m = 0; m < 4; ++m) { bf16_t* rowo = XO + (size_t)(row0 + ai * HALF + m * 16) * DM + col0;
#pragma unroll
                for (int bj = 0; bj < 2; ++bj) { const u32x4 x = xr[ai][m][bj]; f32x4 v0 = acc[ai][bj][m][0], v1 = acc[ai][bj][m][1];
                    v0[0] += __builtin_bit_cast(float, x.x << 16); v0[1] += __builtin_bit_cast(float, x.x & 0xffff0000u); v0[2] += __builtin_bit_cast(float, x.y << 16); v0[3] += __builtin_bit_cast(float, x.y & 0xffff0000u);
                    v1[0] += __builtin_bit_cast(float, x.z << 16); v1[1] += __builtin_bit_cast(float, x.z & 0xffff0000u); v1[2] += __builtin_bit_cast(float, x.w << 16); v1[3] += __builtin_bit_cast(float, x.w & 0xffff0000u);
                    *(PG8_GAS u32x4*)(rowo + bj * HALF) = pk8(v0, v1); } }
    }
};
struct EpiGateUp {
    static constexpr bool PERM = true, AFTER_DRAIN = false;
    bf16_t* ACT; const PG8_LAS float* sl;
    __device__ __forceinline__ void operator()(const f32x4 (&acc)[2][2][4][2], const Unit& u, int wr, int wc, int fr, int fq) const {
        const int row0 = u.pm * BM + wr * 64 + fr, col0 = u.pn * HALF + wc * 32 + 8 * fq;
#pragma unroll
        for (int ai = 0; ai < 2; ++ai)
#pragma unroll
            for (int m = 0; m < 4; ++m) { const int row = row0 + ai * HALF + m * 16; const float rs = sl[row - u.pm * BM]; f32x4 a[2];
#pragma unroll
                for (int n = 0; n < 2; ++n) { const f32x4 g = acc[ai][0][m][n] * rs, up = acc[ai][1][m][n] * rs;
#pragma unroll
                    for (int j = 0; j < 4; ++j) a[n][j] = g[j] * __builtin_amdgcn_rcpf(1.0f + __builtin_amdgcn_exp2f(-LOG2E * g[j])) * up[j]; }
                *(PG8_GAS u32x4*)(ACT + (size_t)row * FF + col0) = pk8(a[0], a[1]); }
    }
};
struct EpiDown {
    static constexpr bool PERM = true, AFTER_DRAIN = false;
    bf16_t* Y; const PG8_LAS float* sl;
    __device__ __forceinline__ void operator()(const f32x4 (&acc)[2][2][4][2], const Unit& u, int wr, int wc, int fr, int fq) const {
        const int row0 = u.pm * BM + wr * 64 + fr, col0 = u.pn * BM + wc * 32 + 8 * fq;
#pragma unroll
        for (int ai = 0; ai < 2; ++ai)
#pragma unroll
            for (int m = 0; m < 4; ++m) { const int row = row0 + ai * HALF + m * 16; const float ws = sl[row - u.pm * BM]; bf16_t* rowp = Y + (size_t)row * DM + col0;
#pragma unroll
                for (int bj = 0; bj < 2; ++bj) { const f32x4 v0 = acc[ai][bj][m][0] * ws, v1 = acc[ai][bj][m][1] * ws; *(PG8_GAS u32x4*)(rowp + bj * HALF) = pk8(v0, v1); } }
    }
};
struct GroupedOrder {
    int nwg, nN, G, c; const int* blk_e;
    __device__ void init(int n_used, int nN_, int G_, int c_, const int* be) { nN = nN_; nwg = n_used * nN_; G = G_; c = c_; blk_e = be; }
    __device__ bool next(int i, Unit& u) const { const long L = (long)i * G + c; const int grp = (int)(L >> 5), w = (int)(L & 31); const int pm = grp * 8 + (w >> 2); if (pm * nN >= nwg) return false; u.pm = pm; u.pn = w & 3; u.e = ((const PG8_GAS int*)blk_e)[pm]; return true; }
    __device__ __forceinline__ void a_ready(const Unit&) const {}
    __device__ __forceinline__ void done(const Unit&) const {}
};
struct DownOrder {
    int nwg, G, c, r, nB, base, own, y, partA, gmax; const int* blk_e; const PG8_GAS unsigned* qd; const PG8_GAS unsigned* xtab; mutable int seen_own; mutable unsigned relmask;
    __device__ void init(int n_used, int G_, int c_, const int* be, const PG8_GAS unsigned* qd_, const PG8_GAS unsigned* xtab_) { nwg = n_used * 4; G = G_; c = c_; r = nwg % G_; nB = G_ - r; base = nwg / G_; blk_e = be; qd = qd_; xtab = xtab_; seen_own = 1; relmask = 0u;
        int rem = nwg, yA = 0, yB = 0, pA = 0, pB = 0;
        for (int k = 0; rem > 0 && k < 4096; ++k) { const bool isB = (k < 2) || (k & 1); const int cap = isB ? nB : r; if (cap == 0) continue;
            if (rem >= cap) { if (isB) ++yB; else ++yA; rem -= cap; } else { if (isB) pB = rem; else pA = rem; rem = 0; } }
        const bool isA = c_ < r; own = base + (isA ? 1 : 0); y = isA ? yA + (c_ < pA ? 1 : 0) : yB + ((c_ - r) < pB ? 1 : 0); partA = pA; gmax = base + 1 - yA;
#ifndef MOE_DEAL
#define MOE_DEAL 1
#endif
        if (MOE_DEAL == 0) y = own;
        if (yA > base + 1 || yB < base) { y = own; }
    }
    __device__ bool next(int i, Unit& u) const {
        if (i >= y) return false;
        long L;
        if (i < own) L = (long)i * G + c;
        else { const int s = (i - own) * nB + (c - r); int k, cg;
            if (s < (gmax - 1) * r) { k = s / r; cg = s - k * r; } else { k = gmax - 1; cg = s - (gmax - 1) * r + partA; }
            L = (long)(base - k) * G + cg; }
        u.pm = (int)(L >> 2); u.pn = (int)(L & 3); u.e = ((const PG8_GAS int*)blk_e)[u.pm]; return true; }
    __device__ __forceinline__ static void poll_ge(const PG8_GAS unsigned* p, unsigned want) {
        for (unsigned spins = 0; spins < (1u << 22); ++spins) { if ((unsigned)__builtin_amdgcn_readfirstlane((int)__hip_atomic_load(p, __ATOMIC_RELAXED, __HIP_MEMORY_SCOPE_AGENT)) >= want) break; __builtin_amdgcn_s_sleep(2); } }
    __device__ __forceinline__ void a_ready(const Unit& u) const {
        const int q = ((u.pm * 4 + u.pn) % G) >> 2;
        if (q == (c >> 2)) { if (seen_own) return; poll_ge(qd + q * 64, 4u); seen_own = 1; __builtin_amdgcn_fence(__ATOMIC_ACQUIRE, "agent"); asm volatile("s_waitcnt vmcnt(0)" ::: "memory"); }
        else { unsigned xs_[4];
#pragma unroll
            for (int k = 0; k < 4; ++k) xs_[k] = __hip_atomic_load(xtab + q * 4 + k, __ATOMIC_RELAXED, __HIP_MEMORY_SCOPE_AGENT);
#pragma unroll
            for (int k = 0; k < 4; ++k) { const unsigned x = ((unsigned)__builtin_amdgcn_readfirstlane((int)xs_[k]) - 1u) & 15u;
                if (!((relmask >> x) & 1u)) { poll_ge(qd + x * 64 + 17, 1u); relmask |= 1u << x; } } }
    }
    __device__ __forceinline__ void done(const Unit&) const {}
};
template <class Epi, class Sched, bool ALIGN_EPI = false, bool SP2 = false, bool GATHER = false>
__device__ __forceinline__ void gemm_phase(PG8_LAS unsigned char* lds, const Gemm g, const Sched& S, const Epi& E) {
    int tid_ = threadIdx.x; asm volatile("" : "+v"(tid_));
    const int tid = tid_, wid = __builtin_amdgcn_readfirstlane(tid >> 6), lane = tid & 63, wr = wid >> 2, wc = wid & 3, fr = lane & 15, fq = lane >> 4;
    const int K = g.K, nt = K / BK;
    unsigned voffA[2], voffB[2];
#pragma unroll
    for (int i = 0; i < 2; ++i) { int R, C; stage_rc(tid * 16 + i * 8192, R, C); const int Rb = Epi::PERM ? ((R & ~31) + perm32(R & 31)) : R;
        voffA[i] = (unsigned)(R * K + C) * 2u; voffB[i] = (unsigned)(Rb * K + C) * 2u; }
    int gR[2], gC2[2];
#pragma unroll
    for (int i = 0; i < 2; ++i) { int R, C; stage_rc(tid * 16 + i * 8192, R, C); gR[i] = R; gC2[i] = C * 2; }
    unsigned vA[2][2], vN[2][2];
#define PG8_GOFF(dst, pm_) do { _Pragma("unroll") for (int h_ = 0; h_ < 2; ++h_) _Pragma("unroll") for (int i_ = 0; i_ < 2; ++i_) \
        dst[h_][i_] = (unsigned)((const __attribute__((address_space(1))) int*)g.gat)[(pm_) * BM + h_ * HALF + gR[i_]] * (unsigned)(K * 2) + (unsigned)gC2[i_]; } while (0)
    const size_t kstep = (size_t)(BK * 2);
    const size_t hstep = (size_t)HALF * K * 2;
    const size_t tstep = 2 * hstep;
    const unsigned ldsw = (unsigned)wid * 1024u;
    const int aoff = lds_byte(wr * 64 + fr, fq * 8), boff = lds_byte(wc * 32 + fr, fq * 8);
#define PG8_SA(b, h) (((b) * 2 + (h)) * HTB)
#define PG8_SB(b, h) ((4 + (b) * 2 + (h)) * HTB)
#define PG8_STAGE(bufoff, gbase, voff) do { _Pragma("unroll") for (int _i = 0; _i < 2; ++_i) \
        __builtin_amdgcn_global_load_lds((const unsigned*)((const char*)(gbase) + (voff)[_i]), (PG8_LAS unsigned*)(lds + (bufoff) + ldsw + _i * 8192), 16, 0, 0); } while (0)
#define PG8_STAGEA(b, h, ptr, isn) do { if constexpr (GATHER) { unsigned vs_[2]; vs_[0] = (isn) ? vN[h][0] : vA[h][0]; vs_[1] = (isn) ? vN[h][1] : vA[h][1]; PG8_STAGE(PG8_SA(b, h), ptr, vs_); } \
        else { PG8_STAGE(PG8_SA(b, h), (ptr) + (h) * hstep, voffA); } } while (0)
#define PG8_LDA(dst, b, h) do { _Pragma("unroll") for (int m = 0; m < 4; ++m) _Pragma("unroll") for (int k = 0; k < 2; ++k) dst[m][k] = *(const PG8_LAS bf16x8*)(lds + PG8_SA(b, h) + aoff + m * 2048 + k * 1024); } while (0)
#define PG8_LDB(dst, b, h) do { _Pragma("unroll") for (int n = 0; n < 2; ++n) _Pragma("unroll") for (int k = 0; k < 2; ++k) dst[n][k] = *(const PG8_LAS bf16x8*)(lds + PG8_SB(b, h) + boff + n * 2048 + k * 1024); } while (0)
#define PG8_MMA(ai, bj, At, Bt) do { __builtin_amdgcn_s_setprio(1); _Pragma("unroll") for (int m = 0; m < 4; ++m) _Pragma("unroll") for (int n = 0; n < 2; ++n) _Pragma("unroll") for (int k = 0; k < 2; ++k) \
        acc[ai][bj][m][n] = __builtin_amdgcn_mfma_f32_16x16x32_bf16(Bt[n][k], At[m][k], acc[ai][bj][m][n], 0, 0, 0); __builtin_amdgcn_s_setprio(0); } while (0)
#define PG8_WAIT_V(n) asm volatile("s_waitcnt vmcnt(" #n ")" ::: "memory")
#define PG8_WAIT_L(n) asm volatile("s_waitcnt lgkmcnt(" #n ")" ::: "memory")
#define PG8_BAR __builtin_amdgcn_s_barrier()
#define PG8_SCHED __builtin_amdgcn_sched_barrier(0)
    Unit cur, nxt; int ui = 0;
    if (!S.next(0, cur)) return;
    f32x4 acc[2][2][4][2];
#pragma unroll
    for (int a = 0; a < 2; ++a)
#pragma unroll
        for (int b = 0; b < 2; ++b)
#pragma unroll
            for (int m = 0; m < 4; ++m)
#pragma unroll
                for (int n = 0; n < 2; ++n) acc[a][b][m][n] = (f32x4){0.f, 0.f, 0.f, 0.f};
    bf16x8 At[4][2], B0[2][2], B1[2][2];
    const char* cA = (const char*)g.A + (GATHER ? (size_t)0 : (size_t)cur.pm * tstep); if constexpr (GATHER) { PG8_GOFF(vA, cur.pm); } const char* cB = (const char*)g.Bt + (size_t)cur.e * g.bstride + (size_t)cur.pn * tstep;
    S.a_ready(cur);
    if constexpr (SP2) {
        PG8_STAGE(PG8_SB(0, 0), cB, voffB); PG8_STAGE(PG8_SB(0, 1), cB + hstep, voffB); PG8_STAGEA(0, 0, cA, false); PG8_STAGEA(0, 1, cA, false);
        if (wr == 1) PG8_BAR;
        PG8_WAIT_V(2); PG8_BAR;
        PG8_STAGE(PG8_SB(1, 0), cB + kstep, voffB); PG8_STAGEA(1, 0, cA + kstep, false); PG8_STAGE(PG8_SB(1, 1), cB + hstep + kstep, voffB);
        PG8_WAIT_V(6); PG8_BAR;
    } else {
        PG8_STAGE(PG8_SB(0, 0), cB, voffB); PG8_STAGEA(0, 0, cA, false); PG8_STAGE(PG8_SB(0, 1), cB + hstep, voffB); PG8_STAGEA(0, 1, cA, false);
        if (wr == 1) PG8_BAR;
        PG8_WAIT_V(4); PG8_BAR;
        PG8_STAGE(PG8_SB(1, 0), cB + kstep, voffB); PG8_STAGEA(1, 0, cA + kstep, false); PG8_STAGE(PG8_SB(1, 1), cB + hstep + kstep, voffB);
        PG8_WAIT_V(6); PG8_BAR;
    }
    for (;;) {
        const bool has_next = S.next(ui + 1, nxt);
        const char* nA = (has_next && !GATHER) ? (const char*)g.A + (size_t)nxt.pm * tstep : cA; if constexpr (GATHER) { if (has_next) { PG8_GOFF(vN, nxt.pm); } else {
#pragma unroll
            for (int h_ = 0; h_ < 2; ++h_) { vN[h_][0] = vA[h_][0]; vN[h_][1] = vA[h_][1]; } } }
        const char* nB = has_next ? (const char*)g.Bt + (size_t)nxt.e * g.bstride + (size_t)nxt.pn * tstep : cB;
        for (int t = 0; t < nt; t += 2) {
            const bool last = (t == nt - 2);
            const char* a1 = cA + (size_t)(t + 1) * kstep;
            const char* a2 = last ? nA : cA + (size_t)(t + 2) * kstep; const char* b2 = last ? nB : cB + (size_t)(t + 2) * kstep;
            const char* a3 = a2 + kstep; const char* b3 = b2 + kstep;
            if (last && has_next) S.a_ready(nxt);
            if (last && g.scal && wid == 0) __builtin_amdgcn_global_load_lds((const unsigned*)(g.scal + (size_t)cur.pm * BM + lane * 4), (PG8_LAS unsigned*)(uintptr_t)g.scal_lds, 16, 0, 0);
            if constexpr (SP2) {
            PG8_LDB(B0, 0, 0); PG8_LDB(B1, 0, 1); PG8_SCHED; PG8_LDA(At, 0, 0); PG8_STAGEA(1, 1, a1, false);
            PG8_WAIT_V(8); PG8_WAIT_L(0); PG8_BAR; PG8_MMA(0, 0, At, B0); PG8_MMA(0, 1, At, B1); PG8_BAR; PG8_SCHED;
            PG8_LDA(At, 0, 1); PG8_STAGE(PG8_SB(0, 0), b2, voffB); PG8_STAGE(PG8_SB(0, 1), b2 + hstep, voffB); PG8_STAGEA(0, 0, a2, last);
            PG8_WAIT_V(8); PG8_WAIT_L(0); PG8_BAR; PG8_MMA(1, 0, At, B0); PG8_MMA(1, 1, At, B1); PG8_BAR; PG8_SCHED;
            PG8_LDB(B0, 1, 0); PG8_LDB(B1, 1, 1); PG8_SCHED; PG8_LDA(At, 1, 0); PG8_STAGEA(0, 1, a2, last);
            PG8_WAIT_V(8); PG8_WAIT_L(0); PG8_BAR; PG8_MMA(0, 0, At, B0); PG8_MMA(0, 1, At, B1); PG8_BAR; PG8_SCHED;
            PG8_LDA(At, 1, 1); PG8_STAGE(PG8_SB(1, 0), b3, voffB); PG8_STAGE(PG8_SB(1, 1), b3 + hstep, voffB); PG8_STAGEA(1, 0, a3, last);
            PG8_WAIT_V(8); PG8_WAIT_L(0); PG8_BAR; PG8_MMA(1, 0, At, B0); PG8_MMA(1, 1, At, B1); PG8_BAR; PG8_SCHED;
            } else {
            PG8_LDB(B0, 0, 0); PG8_SCHED; PG8_LDA(At, 0, 0); PG8_STAGEA(1, 1, a1, false);
            PG8_WAIT_L(8); PG8_BAR; PG8_WAIT_L(0); PG8_MMA(0, 0, At, B0); PG8_BAR; PG8_SCHED;
            PG8_LDB(B1, 0, 1); PG8_STAGE(PG8_SB(0, 0), b2, voffB);
            PG8_BAR; PG8_WAIT_L(0); PG8_MMA(0, 1, At, B1); PG8_BAR;
            PG8_LDA(At, 0, 1); PG8_STAGEA(0, 0, a2, last);
            PG8_BAR; PG8_WAIT_L(0); PG8_MMA(1, 0, At, B0); PG8_BAR; PG8_SCHED;
            PG8_STAGE(PG8_SB(0, 1), b2 + hstep, voffB);
            PG8_WAIT_V(6); PG8_BAR; PG8_MMA(1, 1, At, B1); PG8_BAR;
            PG8_LDB(B0, 1, 0); PG8_SCHED; PG8_LDA(At, 1, 0); PG8_STAGEA(0, 1, a2, last);
            PG8_WAIT_L(8); PG8_BAR; PG8_WAIT_L(0); PG8_MMA(0, 0, At, B0); PG8_BAR; PG8_SCHED;
            PG8_LDB(B1, 1, 1); PG8_STAGE(PG8_SB(1, 0), b3, voffB);
            PG8_BAR; PG8_WAIT_L(0); PG8_MMA(0, 1, At, B1); PG8_BAR;
            PG8_LDA(At, 1, 1); PG8_STAGEA(1, 0, a3, last);
            PG8_BAR; PG8_WAIT_L(0); PG8_MMA(1, 0, At, B0); PG8_BAR; PG8_SCHED;
            PG8_STAGE(PG8_SB(1, 1), b3 + hstep, voffB);
            PG8_WAIT_V(6); PG8_BAR; PG8_MMA(1, 1, At, B1); PG8_BAR;
            }
        }
        if constexpr (ALIGN_EPI) { if (wr == 0) PG8_BAR; }
        if constexpr (!Epi::AFTER_DRAIN) { E(acc, cur, wr, wc, fr, fq); S.done(cur); }
        if (!has_next) break;
#pragma unroll
        for (int a = 0; a < 2; ++a)
#pragma unroll
            for (int b = 0; b < 2; ++b)
#pragma unroll
                for (int m = 0; m < 4; ++m)
#pragma unroll
                    for (int n = 0; n < 2; ++n) acc[a][b][m][n] = (f32x4){0.f, 0.f, 0.f, 0.f};
        cur = nxt; cA = nA; cB = nB; ++ui;
        if constexpr (GATHER) {
#pragma unroll
            for (int h_ = 0; h_ < 2; ++h_) { vA[h_][0] = vN[h_][0]; vA[h_][1] = vN[h_][1]; } }
        if constexpr (ALIGN_EPI) { if (wr == 1) PG8_BAR; }
    }
    PG8_WAIT_V(0);
    if constexpr (!ALIGN_EPI) { if (wr == 0) PG8_BAR; }
    PG8_BAR;
    if constexpr (Epi::AFTER_DRAIN) { E.fused(acc, cur, wr, wc, fr, fq, lds, wid, lane); S.done(cur); }
#undef PG8_SA
#undef PG8_SB
#undef PG8_STAGE
#undef PG8_LDA
#undef PG8_STAGEA
#undef PG8_GOFF
#undef PG8_LDB
#undef PG8_MMA
#undef PG8_WAIT_V
#undef PG8_WAIT_L
#undef PG8_BAR
#undef PG8_SCHED
}
}
#define GAS __attribute__((address_space(1)))
#define LAS __attribute__((address_space(3)))
typedef unsigned short bf16;
typedef unsigned v4u __attribute__((ext_vector_type(4)));
typedef float f32x4 __attribute__((ext_vector_type(4)));
typedef short bf16x8 __attribute__((ext_vector_type(8)));
typedef GAS unsigned gu32;
typedef GAS unsigned long long gu64;
#define RLX_AGENT __ATOMIC_RELAXED, __HIP_MEMORY_SCOPE_AGENT
#define LDS_WAIT() asm volatile("s_waitcnt lgkmcnt(0)" ::: "memory")
#define VM_WAIT() asm volatile("s_waitcnt vmcnt(0)" ::: "memory")
__device__ __forceinline__ unsigned long long rt() { return __builtin_amdgcn_s_memrealtime(); }
__device__ __forceinline__ unsigned f2bf(float f) { unsigned u = __builtin_bit_cast(unsigned, f); return (u + 0x7fffu + ((u >> 16) & 1u)) >> 16; }
__device__ __forceinline__ unsigned pk2(float lo, float hi) { return f2bf(lo) | (f2bf(hi) << 16); }
#define XB_TMO      128
#define XB_XCNT(j)  (256  + 64 * (j))
#define XB_XSUB(j)  (1280 + 64 * (j))
#define XB_XGEN(j)  (2304 + 64 * (j))
#define XB_TOP      3328
#define XB_TOPGEN   3392
#define XCD_BAR_WORDS 3456
#define XB_SPIN_CAP (1u << 18)

__device__ __forceinline__ unsigned xb_ld(unsigned* p)              { return __hip_atomic_load(p, __ATOMIC_RELAXED, __HIP_MEMORY_SCOPE_AGENT); }
__device__ __forceinline__ unsigned xb_add(unsigned* p, unsigned v) { return __hip_atomic_fetch_add(p, v, __ATOMIC_RELAXED, __HIP_MEMORY_SCOPE_AGENT); }
__device__ __forceinline__ unsigned xb_xcc_id() { return (unsigned)__builtin_amdgcn_s_getreg((3 << 11) | 20) & 0xFu; }
#define XB_SPIN(cond, bar) do { unsigned _sp = 0; while (cond) { __builtin_amdgcn_s_sleep(1); \
    if ((++_sp & 255u) == 0u) { if (xb_ld(&(bar)[XB_TMO])) break; if (_sp > XB_SPIN_CAP) { atomicAdd(&(bar)[XB_TMO], 1u); break; } } } } while (0)

struct XcdBarrier {
    unsigned* bar; unsigned x;
    volatile LAS unsigned* st;
};

__device__ __forceinline__ XcdBarrier xcd_barrier_post(unsigned* bar, volatile LAS unsigned* st) {
    XcdBarrier b; b.bar = bar; b.x = xb_xcc_id(); b.st = st;
    if (threadIdx.x == 0) (void)xb_add(&bar[XB_XCNT(b.x)], 1u);
    return b;
}
__device__ __forceinline__ void xcd_barrier_complete(unsigned* bar, unsigned x, unsigned& nloc, unsigned& nx) {
    const unsigned G = gridDim.x * gridDim.y * gridDim.z;
    unsigned sum, cnt, mine, sp = 0u;
    for (;;) {
        sum = 0u; cnt = 0u; mine = 0u;
#pragma unroll
        for (unsigned j = 0; j < 16; ++j) { const unsigned c = xb_ld(&bar[XB_XCNT(j)]); sum += c; cnt += (c > 0u) ? 1u : 0u; mine = (j == x) ? c : mine; }
        if (sum == G) break;
        __builtin_amdgcn_s_sleep(1);
        if ((++sp & 255u) == 0u) { if (xb_ld(&bar[XB_TMO])) break; if (sp > XB_SPIN_CAP) { atomicAdd(&bar[XB_TMO], 1u); break; } }
    }
    nloc = mine > 0u ? mine : 1u; nx = cnt > 0u ? cnt : 1u;
}

__device__ __forceinline__ void xcd_barrier(const XcdBarrier& b) {
    asm volatile("s_waitcnt vmcnt(0)" ::: "memory");
    __syncthreads();
    if (threadIdx.x == 0) {
        unsigned* bar = b.bar;
        __builtin_amdgcn_s_waitcnt(0);
        unsigned nloc = b.st[0], nx = b.st[1];
        if (nloc == 0u) { xcd_barrier_complete(bar, b.x, nloc, nx); b.st[0] = nloc; b.st[1] = nx; }
        const unsigned old = xb_add(&bar[XB_XSUB(b.x)], 1u);
        const unsigned gen = old / nloc;
        if (old + 1u == (gen + 1u) * nloc) {
            __builtin_amdgcn_fence(__ATOMIC_RELEASE, "agent");
            asm volatile("s_waitcnt vmcnt(0)" ::: "memory");
            const unsigned og = xb_add(&bar[XB_TOP], 1u);
            const unsigned tg = og / nx;
            if (og + 1u == (tg + 1u) * nx) xb_add(&bar[XB_TOPGEN], 1u);
            else XB_SPIN(xb_ld(&bar[XB_TOPGEN]) == tg, bar);
            __builtin_amdgcn_fence(__ATOMIC_ACQUIRE, "agent");
            xb_add(&bar[XB_XGEN(b.x)], 1u);
            asm volatile("s_waitcnt vmcnt(0)" ::: "memory");
        } else {
            XB_SPIN(xb_ld(&bar[XB_XGEN(b.x)]) == gen, bar);
            __builtin_amdgcn_fence(__ATOMIC_ACQUIRE, "agent");
            asm volatile("s_waitcnt vmcnt(0)" ::: "memory");
        }
    }
    __syncthreads();
}

typedef float f32x16 __attribute__((ext_vector_type(16)));
typedef float f32x2 __attribute__((ext_vector_type(2)));
typedef unsigned u32x2g __attribute__((ext_vector_type(2)));
typedef short v4i16_t __attribute__((ext_vector_type(4)));
enum { IN_X = 0, IN_RELB, IN_LN1G, IN_WIN, IN_LQ1, IN_LK1, IN_LQ2, IN_LK2, IN_SUBLN, IN_CONVW, IN_CONVB, IN_CLNG, IN_CLNB, IN_SLRE, IN_SLIM, IN_SLDT, IN_SBRE, IN_SBIM, IN_SCRE, IN_SCIM,
       IN_SD, IN_GLUW, IN_GLUB, IN_WOUT, IN_LN2G, IN_GRW, IN_GRB, IN_ERW, IN_ERB, IN_WG, IN_WU, IN_WD, IN_FING, N_IN };
struct Args { const float* in[N_IN]; float* out; unsigned char* ws; int ph_lo, ph_hi; };
#define CAS __attribute__((address_space(4)))
struct ArgsV { const float* const CAS* in; };
__device__ __forceinline__ ArgsV args_view() { const float* const CAS* p = (const float* const CAS*)__builtin_amdgcn_kernarg_segment_ptr(); asm volatile("" : "+s"(p)); return ArgsV{p}; }
#define UNIT_IDS int tid_u_ = threadIdx.x; asm volatile("" : "+v"(tid_u_)); const int tid = tid_u_, lane = tid & 63, wave = __builtin_amdgcn_readfirstlane(tid >> 6); (void)tid; (void)lane; (void)wave
struct Frame {
    LAS unsigned char* lds; volatile LAS unsigned* MISC; gu32* ctl;
    int tid, lane, wave, vcu, G;
    unsigned char* ws; float* out;
};
__device__ __forceinline__ unsigned pkb(float lo, float hi) { return pg8::pk_bf16(lo, hi); }
__device__ __forceinline__ float bf2f(unsigned short b) { return __builtin_bit_cast(float, (unsigned)b << 16); }
__device__ __forceinline__ float bflo(unsigned w) { return __builtin_bit_cast(float, w << 16); }
__device__ __forceinline__ float bfhi(unsigned w) { return __builtin_bit_cast(float, w & 0xffff0000u); }
__device__ __forceinline__ float xchg32(float v, int lane) { return __builtin_bit_cast(float, __builtin_amdgcn_ds_bpermute((lane ^ 32) << 2, __builtin_bit_cast(int, v))); }
template <int CTRL> __device__ __forceinline__ float dpp_mov(float v) { return __builtin_bit_cast(float, __builtin_amdgcn_update_dpp(0, __builtin_bit_cast(int, v), CTRL, 0xf, 0xf, true)); }
__device__ __forceinline__ float wave_sum(float v) {
    v += dpp_mov<0xB1>(v);
    v += dpp_mov<0x4E>(v);
    v += dpp_mov<0x141>(v);
    v += dpp_mov<0x140>(v);
    const int b = __builtin_bit_cast(int, v);
    return (__builtin_bit_cast(float, __builtin_amdgcn_readlane(b, 0)) + __builtin_bit_cast(float, __builtin_amdgcn_readlane(b, 16))) + (__builtin_bit_cast(float, __builtin_amdgcn_readlane(b, 32)) + __builtin_bit_cast(float, __builtin_amdgcn_readlane(b, 48)));
}
__device__ __forceinline__ float sigmoidf_(float x) { return __builtin_amdgcn_rcpf(1.0f + __builtin_amdgcn_exp2f(-LOG2E * x)); }
__device__ __forceinline__ float gelu_tanh(float y) {
    const float u2 = 1.5957691216057308f * (y + 0.044715f * y * y * y);
    return y * sigmoidf_(u2);
}

struct TrDesc { const float* src; const float* gain; bf16* dst; int N, K; };
__device__ __forceinline__ TrDesc tr_desc(const ArgsV& A, unsigned char* ws, int it) {
    constexpr int I_SMALL = 1152 + 512 + 32, I_EXP = 768;
    TrDesc d;
    if (it < 2 * I_SMALL) {
        const int l = it / I_SMALL; int r = it % I_SMALL;
        if (r < 1152) { const int kb = r / 72, nb = r % 72; d.N = NCOL; d.K = DM; d.src = A.in[IN_WIN] + (size_t)l * DM * NCOL + (size_t)(64 * kb) * NCOL + 32 * nb; d.gain = A.in[IN_LN1G] + l * DM + 64 * kb;
            const int tl_ = nb >> 3, tp_ = (tl_ == 8) ? 6 : (tl_ >= 6 ? tl_ + 1 : tl_);
            d.dst = (bf16*)(ws + WS_WIN) + (size_t)l * NCOL * DM + (size_t)(32 * (tp_ * 8 + (nb & 7))) * DM + 64 * kb; return d; }
        r -= 1152;
        if (r < 512) { const int kb = r / 32, nb = r % 32; d.N = DM; d.K = DM; d.src = A.in[IN_WOUT] + (size_t)l * DM * DM + (size_t)(64 * kb) * DM + 32 * nb; d.gain = nullptr;
            d.dst = (bf16*)(ws + WS_WOUT) + (size_t)l * DM * DM + (size_t)(32 * nb) * DM + 64 * kb; return d; }
        r -= 512;
        { const int kb = r / 8, nb = r % 8; d.N = 256; d.K = 256; d.src = A.in[IN_GLUW] + (size_t)l * 256 * 256 + (size_t)(64 * kb) * 256 + 32 * nb; d.gain = nullptr;
            d.dst = (bf16*)(ws + WS_WGLU) + (size_t)l * 256 * 256 + (size_t)(32 * nb) * 256 + 64 * kb; return d; }
    }
    const int r = it - 2 * I_SMALL, le = r / I_EXP, q = r % I_EXP, l = le / NE, mat = q >> 8, idx = q & 255;
    if (mat < 2) { const int kb = idx >> 4, nb = idx & 15, n0 = 32 * nb; d.N = FF; d.K = DM; d.src = A.in[mat == 0 ? IN_WG : IN_WU] + (size_t)le * DM * FF + (size_t)(64 * kb) * FF + n0; d.gain = A.in[IN_LN2G] + l * DM + 64 * kb;
        d.dst = (bf16*)(ws + WS_WGU) + (size_t)le * 1024 * 1024 + (size_t)((n0 >> 7) * 256 + (n0 & 127) + (mat ? 128 : 0)) * DM + 64 * kb; return d; }
    { const int kb = idx >> 5, nb = idx & 31; d.N = DM; d.K = FF; d.src = A.in[IN_WD] + (size_t)le * FF * DM + (size_t)(64 * kb) * DM + 32 * nb; d.gain = nullptr;
        d.dst = (bf16*)(ws + WS_WDN) + (size_t)le * DM * FF + (size_t)(32 * nb) * FF + 64 * kb; return d; }
}
struct TrGain { f32x4 g0, g1; };
__device__ __forceinline__ TrGain tr_gain(const TrDesc& d, int lane) { TrGain gg; gg.g0 = f32x4{1.f, 1.f, 1.f, 1.f}; gg.g1 = gg.g0;
    if (d.gain) { gg.g0 = *(const GAS f32x4*)(d.gain + 8 * (lane & 7)); gg.g1 = *(const GAS f32x4*)(d.gain + 8 * (lane & 7) + 4); } return gg; }
__device__ __forceinline__ void tr_load(const TrDesc& d, float (&v)[32], int lane) {
    const GAS float* p = (const GAS float*)d.src + (size_t)(lane >> 5) * d.N + (lane & 31);
#pragma unroll
    for (int i = 0; i < 32; ++i) v[i] = __builtin_nontemporal_load(p + (size_t)(2 * i) * d.N);
}
__device__ __forceinline__ void tr_finish(const TrDesc& d, const float (&v)[32], const TrGain& gg, LAS float* scr, int lane) {
#pragma unroll
    for (int i = 0; i < 32; ++i) scr[(2 * i + (lane >> 5)) * 33 + (lane & 31)] = v[i];
    LDS_WAIT(); asm volatile("" ::: "memory");
    const int c = lane & 7;
    const f32x4 g0 = gg.g0, g1 = gg.g1;
#pragma unroll
    for (int j = 0; j < 4; ++j) { const int n = (lane >> 3) + 8 * j; const LAS float* s = scr + (8 * c) * 33 + n;
        v4u o; o.x = pkb(s[0 * 33] * g0.x, s[1 * 33] * g0.y); o.y = pkb(s[2 * 33] * g0.z, s[3 * 33] * g0.w); o.z = pkb(s[4 * 33] * g1.x, s[5 * 33] * g1.y); o.w = pkb(s[6 * 33] * g1.z, s[7 * 33] * g1.w);
        *(GAS v4u*)(d.dst + (size_t)n * d.K + 8 * c) = o; }
    LDS_WAIT(); asm volatile("" ::: "memory");
}
__device__ __forceinline__ void convert_items(Frame& F, const ArgsV& A, int it0, int it1) {
    LAS float* scr = (LAS float*)(F.lds + RING_OFF + F.wave * 16384);
    const int gw = F.vcu * 8 + F.wave, NGW = F.G * 8, lane = F.lane;
    unsigned char* ws = F.ws;
    int it = it0 + gw;
    if (it < it1) { TrDesc cur = tr_desc(A, ws, it); float va[32], vb[32]; tr_load(cur, va, lane);
#pragma unroll 1
        for (;;) {
            const int it1_ = it + NGW; TrDesc nx; const bool h1 = it1_ < it1; const TrGain ga = tr_gain(cur, lane); if (h1) { nx = tr_desc(A, ws, it1_); tr_load(nx, vb, lane); }
            tr_finish(cur, va, ga, scr, lane);
            if (!h1) break;
            const int it2 = it1_ + NGW; const bool h2 = it2 < it1; const TrGain gb = tr_gain(nx, lane); if (h2) { cur = tr_desc(A, ws, it2); tr_load(cur, va, lane); }
            tr_finish(nx, vb, gb, scr, lane);
            if (!h2) break;
            it = it2; } }
}
__device__ __forceinline__ void p0_prologue(Frame& F, const ArgsV& A) {
    LAS float* scr = (LAS float*)(F.lds + RING_OFF + F.wave * 16384);
    const int gw = F.vcu * 8 + F.wave, NGW = F.G * 8, lane = F.lane;
    unsigned char* ws = F.ws;
    convert_items(F, A, 0, 2 * (1152 + 512 + 32));
    const int gt = F.vcu * 512 + F.tid, NGT = F.G * 512;
    for (int i = gt; i < 2 * 64 * 1024; i += NGT) {
        const int l = i >> 16, n = (i >> 10) & 63, k = i & 1023; float v = 0.f; const float g = A.in[IN_LN2G][l * DM + k];
        if (n < 32) v = A.in[IN_ERW][((size_t)l * DM + k) * 32 + n] * g; else if (n < 36) v = A.in[IN_GRW][((size_t)l * DM + k) * 4 + (n - 32)] * g;
        ((bf16*)(ws + WS_WRT))[i] = (bf16)f2bf(v);
    }
    if ((gt & 31) == 0) for (int i = gt >> 5; i < 2 * 1024; i += NGT >> 5) {
        const int l = i >> 10, gp = i & 1023, g = gp >> 6;
        float* P = (float*)(ws + MS_SSMP) + (size_t)l * SP_END;
        const GAS f32x4* sbr = (const GAS f32x4*)(A.in[IN_SBRE] + ((size_t)l * 1024 + gp) * 16); const GAS f32x4* sbi = (const GAS f32x4*)(A.in[IN_SBIM] + ((size_t)l * 1024 + gp) * 16);
        f32x4 bre[4], bim[4];
#pragma unroll
        for (int q = 0; q < 4; ++q) { bre[q] = sbr[q]; bim[q] = sbi[q]; }
        const float dt = expf(((const GAS float*)A.in[IN_SLDT])[l * 16 + g]), lr = ((const GAS float*)A.in[IN_SLRE])[l * 1024 + gp], li = ((const GAS float*)A.in[IN_SLIM])[l * 1024 + gp];
        const float mag = expf(lr * dt), ar = mag * cosf(li * dt), ai = mag * sinf(li * dt), den = lr * lr + li * li;
        const float zr = ((ar - 1.0f) * lr + ai * li) / den, zi = (ai * lr - (ar - 1.0f) * li) / den;
        P[SP_AR + gp] = ar; P[SP_AI + gp] = ai;
        float pr = ar, pi = ai;
#pragma unroll
        for (int s = 0; s < 7; ++s) { const float nr = pr * pr - pi * pi, ni = 2.0f * pr * pi; pr = nr; pi = ni; }
        P[SP_ARL + gp] = pr; P[SP_AIL + gp] = pi;
#pragma unroll
        for (int q = 0; q < 4; ++q) { *(GAS f32x4*)(P + SP_BBR + gp * 16 + 4 * q) = zr * bre[q] - zi * bim[q]; *(GAS f32x4*)(P + SP_BBI + gp * 16 + 4 * q) = zr * bim[q] + zi * bre[q]; }
    }
    for (int i = gt; i < 2 * 16 * 16 * 128; i += NGT) {
        const int l = i >> 15, g = (i >> 11) & 15, h = (i >> 7) & 15, pp = i & 127;
        const float v = (pp & 1) ? -A.in[IN_SCIM][(((size_t)l * 16 + g) * 16 + h) * 64 + (pp >> 1)] : A.in[IN_SCRE][(((size_t)l * 16 + g) * 16 + h) * 64 + (pp >> 1)];
        ((bf16*)(ws + MS_SSMC))[i] = (bf16)f2bf(v);
    }
    for (int i = gt; i < 4 * 132; i += NGT) {
        const int h = i / 132, n = i % 132; int bucket;
        if (n < 16) bucket = n; else if (n >= 128) bucket = 31; else { const float nf = (float)n; int lg = 16 + (int)(logf(nf / 16.0f) / 2.0794415416798357f * 16.0f); bucket = lg < 31 ? lg : 31; }
        ((float*)(ws + MS_LUT))[i] = A.in[IN_RELB][bucket * 4 + h] * LOG2E;
    }
    if (gt < 2) { const int l = gt; float s1 = 0.f, s2 = 0.f;
        for (int d = 0; d < 64; ++d) { s1 += A.in[IN_LQ1][l * 64 + d] * A.in[IN_LK1][l * 64 + d]; s2 += A.in[IN_LQ2][l * 64 + d] * A.in[IN_LK2][l * 64 + d]; }
        const float lam_init = 0.8f - 0.6f * expf(-0.3f * (float)l);
        ((float*)(ws + MS_LAM))[l] = expf(s1) - expf(s2) + lam_init; ((float*)(ws + MS_LAM))[2 + l] = 1.0f - lam_init; }
#pragma unroll 1
    for (int m0 = gw; m0 < NTOK; m0 += 4 * NGW) {
        f32x4 xv[4][4];
#pragma unroll
        for (int q = 0; q < 4; ++q) { const int m = (m0 + q * NGW < NTOK) ? m0 + q * NGW : m0; const GAS f32x4* xr = (const GAS f32x4*)(A.in[IN_X] + (size_t)m * DM) + lane;
#pragma unroll
            for (int j = 0; j < 4; ++j) xv[q][j] = xr[64 * j]; }
#pragma unroll
        for (int q = 0; q < 4; ++q) if (m0 + q * NGW < NTOK) { const int m = m0 + q * NGW; float s = 0.f;
            GAS unsigned long long* o8 = (GAS unsigned long long*)((bf16*)(ws + WS_XB) + (size_t)m * DM) + lane;
#pragma unroll
            for (int j = 0; j < 4; ++j) { const f32x4 v = xv[q][j]; s += (v.x * v.x + v.y * v.y) + (v.z * v.z + v.w * v.w);
                o8[64 * j] = (unsigned long long)pkb(v.x, v.y) | ((unsigned long long)pkb(v.z, v.w) << 32); }
            s = wave_sum(s); if (lane == 0) ((GAS float*)(ws + MS_ROWSS))[m] = s; }
    }
}

#define LDS_BAR() asm volatile("s_waitcnt lgkmcnt(0)\n\ts_barrier" ::: "memory")
constexpr int US_STRIDE = 528;
struct URaw { v4u a, b; };
__device__ __forceinline__ URaw ssm_fetch_u(Frame& F, int tok0, int tid) {
    const int row = tid >> 4, ch = (tid & 15) * 16;
    const bf16* src = (const bf16*)(F.ws + WS_PROJ) + (size_t)(tok0 + row) * NCOLP + COL_SSM + ch;
    URaw r; r.a = *(const GAS v4u*)src; r.b = *(const GAS v4u*)(src + 8); return r;
}
__device__ __forceinline__ void ssm_store_u(Frame& F, const URaw& r, int tid) {
    const int row = tid >> 4, ch = (tid & 15) * 16;
    LAS v4u* d = (LAS v4u*)(F.lds + row * US_STRIDE + ch * 2); d[0] = r.a; d[1] = r.b;
}
__device__ __forceinline__ bf16x8 ssm_bfrag(const float* P, int off, int g, int p, int hi) {
    const GAS f32x4* s4 = (const GAS f32x4*)(P + off + (g * 64 + p) * 16 + 8 * hi); const f32x4 a = s4[0], b = s4[1];
    v4u t; t.x = pkb(a.x, a.y); t.y = pkb(a.z, a.w); t.z = pkb(b.x, b.y); t.w = pkb(b.z, b.w); return __builtin_bit_cast(bf16x8, t);
}
struct SsmBu { f32x16 rx, ry, ix, iy; };
__device__ __forceinline__ void ssm_bu(SsmBu& o, const LAS unsigned char* Ub, int g, int r32, int hi, const bf16x8 (&bf)[4]) {
    const bf16x8 u1 = *(const LAS bf16x8*)(Ub + r32 * US_STRIDE + g * 32 + hi * 16);
    const bf16x8 u2 = *(const LAS bf16x8*)(Ub + (r32 ^ 4) * US_STRIDE + g * 32 + hi * 16);
    f32x16 z;
#pragma unroll
    for (int r = 0; r < 16; ++r) z[r] = 0.f;
#define SSM_SEL(dst, fa, fb, swapd) do { const f32x16 m1_ = __builtin_amdgcn_mfma_f32_32x32x16_bf16(u1, fa, z, 0, 0, 0), m2_ = __builtin_amdgcn_mfma_f32_32x32x16_bf16(u2, fb, z, 0, 0, 0); \
        _Pragma("unroll") for (int r = 0; r < 16; ++r) dst[r] = (swapd) ? (hi ? m1_[r] : m2_[r]) : (hi ? m2_[r] : m1_[r]); asm volatile("" : "+v"(dst)); __builtin_amdgcn_sched_barrier(0); } while (0)
    SSM_SEL(o.rx, bf[0], bf[1], false);
    SSM_SEL(o.ry, bf[1], bf[0], true);
    SSM_SEL(o.ix, bf[2], bf[3], false);
    SSM_SEL(o.iy, bf[3], bf[2], true);
#undef SSM_SEL
}
#define SSM_BUR(o, t) ((((t) & 7) < 4) ? (o).rx[4 * ((t) >> 3) + ((t) & 3)] : (o).ry[4 * ((t) >> 3) + ((t) & 3)])
#define SSM_BUI(o, t) ((((t) & 7) < 4) ? (o).ix[4 * ((t) >> 3) + ((t) & 3)] : (o).iy[4 * ((t) >> 3) + ((t) & 3)])
__device__ __forceinline__ void ssmA_unit(Frame& F, int l, int u) {
    UNIT_IDS;
    const int b = u / SSM_NRUN, r = u % SSM_NRUN, tok0 = b * SEQ + r * SSM_RUN, r32 = lane & 31, hi = lane >> 5;
    const float* P = (const float*)(F.ws + MS_SSMP) + (size_t)l * SP_END; const LAS unsigned char* Ub = (const LAS unsigned char*)(F.lds);
    bf16x8 bfr[2][4]; float ar[2], ai[2], sr[2] = {0.f, 0.f}, si[2] = {0.f, 0.f};
#pragma unroll
    for (int gi = 0; gi < 2; ++gi) { const int g = wave * 2 + gi; ar[gi] = ((const GAS float*)P)[SP_AR + g * 64 + lane]; ai[gi] = ((const GAS float*)P)[SP_AI + g * 64 + lane];
        bfr[gi][0] = ssm_bfrag(P, SP_BBR, g, r32, hi); bfr[gi][1] = ssm_bfrag(P, SP_BBR, g, r32 + 32, hi); bfr[gi][2] = ssm_bfrag(P, SP_BBI, g, r32, hi); bfr[gi][3] = ssm_bfrag(P, SP_BBI, g, r32 + 32, hi); }
    { const URaw raw = ssm_fetch_u(F, tok0, tid); ssm_store_u(F, raw, tid); }
    LDS_BAR();
#pragma unroll 1
    for (int sc = 0; sc < 4; ++sc) {
        URaw raw; if (sc < 3) raw = ssm_fetch_u(F, tok0 + (sc + 1) * 32, tid);
#pragma unroll
        for (int gi = 0; gi < 2; ++gi) { SsmBu bu; ssm_bu(bu, Ub, wave * 2 + gi, r32, hi, bfr[gi]);
#pragma unroll
            for (int t = 0; t < 32; ++t) { float t1 = __builtin_fmaf(-ai[gi], si[gi], SSM_BUR(bu, t)); asm volatile("" : "+v"(t1));
                const float nr = __builtin_fmaf(ar[gi], sr[gi], t1), ni = __builtin_fmaf(ar[gi], si[gi], __builtin_fmaf(ai[gi], sr[gi], SSM_BUI(bu, t))); sr[gi] = nr; si[gi] = ni; }
            __builtin_amdgcn_sched_barrier(0); }
        LDS_BAR();
        if (sc < 3) { ssm_store_u(F, raw, tid); LDS_BAR(); }
    }
    GAS f32x2* S = (GAS f32x2*)(F.ws + WS_SSM) + (((size_t)(b * SSM_NRUN + r)) * 16 + wave * 2) * 64 + lane;
    S[0] = (f32x2){sr[0], si[0]}; S[64] = (f32x2){sr[1], si[1]};
}
__device__ __forceinline__ void conv_unit(Frame& F, const ArgsV& A, int l, int u) {
    UNIT_IDS;
    const int b = u >> 7, t0 = (u & 127) * 64;
    LAS float* H = (LAS float*)(F.lds);
    const bf16* PR = (const bf16*)(F.ws + WS_PROJ) + (size_t)b * SEQ * NCOLP;
    const int c2 = (tid & 127) * 2, qtr = tid >> 7;
    f32x2 w2[31];
#pragma unroll
    for (int k = 0; k < 31; ++k) w2[k] = *(const GAS f32x2*)((const GAS float*)A.in[IN_CONVW] + ((size_t)l * 31 + k) * 256 + c2);
    const f32x2 bias2 = *(const GAS f32x2*)((const GAS float*)A.in[IN_CONVB] + l * 256 + c2);
    const f32x4 lg = *(const GAS f32x4*)(A.in[IN_CLNG] + l * 256 + lane * 4), lb = *(const GAS f32x4*)(A.in[IN_CLNB] + l * 256 + lane * 4);
    { v4u av[6], gv[6]; const int c8 = (tid & 31) * 8;
#pragma unroll
      for (int pass = 0; pass < 6; ++pass) { const int r = pass * 16 + (tid >> 5), t = t0 - 30 + r; av[pass] = (v4u){0u, 0u, 0u, 0u}; gv[pass] = av[pass];
          if (r < 94 && t >= 0) { const bf16* src = PR + (size_t)t * NCOLP + COL_CONV + c8; av[pass] = *(const GAS v4u*)src; gv[pass] = *(const GAS v4u*)(src + 256); } }
#pragma unroll
      for (int pass = 0; pass < 6; ++pass) { const int r = pass * 16 + (tid >> 5);
          if (r < 94) { const v4u a = av[pass], g = gv[pass];
              const f32x4 h0 = (f32x4){bflo(a.x) * sigmoidf_(bflo(g.x)), bfhi(a.x) * sigmoidf_(bfhi(g.x)), bflo(a.y) * sigmoidf_(bflo(g.y)), bfhi(a.y) * sigmoidf_(bfhi(g.y))};
              const f32x4 h1 = (f32x4){bflo(a.z) * sigmoidf_(bflo(g.z)), bfhi(a.z) * sigmoidf_(bfhi(g.z)), bflo(a.w) * sigmoidf_(bflo(g.w)), bfhi(a.w) * sigmoidf_(bfhi(g.w))};
              LAS f32x4* d = (LAS f32x4*)(H + r * 256 + c8); d[0] = h0; d[1] = h1; } } }
    LDS_BAR();
    f32x2 acc2[16];
#pragma unroll
    for (int tb = 0; tb < 2; ++tb) { f32x2 hv[38];
#pragma unroll
        for (int i = 0; i < 38; ++i) hv[i] = *(const LAS f32x2*)(H + (qtr * 16 + tb * 8 + i) * 256 + c2);
#pragma unroll
        for (int o = 0; o < 8; ++o) { f32x2 a = bias2;
#pragma unroll
            for (int k = 0; k < 31; ++k) a = __builtin_elementwise_fma(w2[k], hv[o + k], a);
            acc2[tb * 8 + o] = a; } }
    LDS_BAR();
#pragma unroll
    for (int i = 0; i < 16; ++i) *(LAS f32x2*)(H + (qtr * 16 + i) * 256 + c2) = acc2[i];
    LDS_BAR();
    bf16* MX = (bf16*)(F.ws + WS_MIX) + ((size_t)b * SEQ + t0) * DM + 512 + lane * 4;
#pragma unroll 2
    for (int i = 0; i < 8; ++i) { const int tk = wave * 8 + i; const f32x4 v = *(const LAS f32x4*)(H + tk * 256 + lane * 4);
        const float mean = wave_sum((v.x + v.y) + (v.z + v.w)) * (1.0f / 256.0f); const f32x4 d = v - mean;
        const float var = wave_sum((d.x * d.x + d.y * d.y) + (d.z * d.z + d.w * d.w)) * (1.0f / 256.0f); const float rstd = __builtin_amdgcn_rsqf(var + LN_EPS_C);
        f32x4 y = d * rstd * lg + lb; y = (f32x4){y.x * sigmoidf_(y.x), y.y * sigmoidf_(y.y), y.z * sigmoidf_(y.z), y.w * sigmoidf_(y.w)};
        u32x2g o; o.x = pkb(y.x, y.y); o.y = pkb(y.z, y.w); *(GAS u32x2g*)(MX + (size_t)tk * DM) = o; }
    LDS_BAR();
}
constexpr int XS_STRIDE = 136, XS_WAVE = 32 * XS_STRIDE;
constexpr int GT_STRIDE = 264;
constexpr int SSMC_XS_OFF = 32768, SSMC_GT_OFF = SSMC_XS_OFF + 8 * XS_WAVE * 2;
static_assert(SSMC_GT_OFF + 32 * GT_STRIDE * 2 <= RING_BYTES, "SSM-C LDS");
__device__ __forceinline__ void ssmC_unit(Frame& F, const ArgsV& A, int l, int u) {
    UNIT_IDS;
    const int b = u / SSM_NRUN, r = u % SSM_NRUN, tok0 = b * SEQ + r * SSM_RUN, fr = lane & 15, fq = lane >> 4;
    const float* P = (const float*)(F.ws + MS_SSMP) + (size_t)l * SP_END; const LAS unsigned char* Ub = (const LAS unsigned char*)(F.lds); const int r32 = lane & 31, hi = lane >> 5;
    LAS bf16* Xs = (LAS bf16*)(F.lds + SSMC_XS_OFF) + wave * XS_WAVE; LAS bf16* Gt = (LAS bf16*)(F.lds + SSMC_GT_OFF);
    const bf16* Cm = (const bf16*)(F.ws + MS_SSMC) + (size_t)l * 16 * 16 * 128;
    const bf16* WG = (const bf16*)(F.ws + WS_WGLU) + (size_t)l * 256 * 256;
    { const URaw raw = ssm_fetch_u(F, tok0, tid); ssm_store_u(F, raw, tid); }
    bf16x8 bfr[2][4]; float ar[2], ai[2];
#pragma unroll
    for (int gi = 0; gi < 2; ++gi) { const int g = wave * 2 + gi; ar[gi] = ((const GAS float*)P)[SP_AR + g * 64 + lane]; ai[gi] = ((const GAS float*)P)[SP_AI + g * 64 + lane];
        bfr[gi][0] = ssm_bfrag(P, SP_BBR, g, r32, hi); bfr[gi][1] = ssm_bfrag(P, SP_BBR, g, r32 + 32, hi); bfr[gi][2] = ssm_bfrag(P, SP_BBI, g, r32, hi); bfr[gi][3] = ssm_bfrag(P, SP_BBI, g, r32 + 32, hi); }
    float xr[2] = {0.f, 0.f}, xi[2] = {0.f, 0.f};
    { float arL[2], aiL[2], dvs_[2]; const GAS f32x2* Sp[2];
#pragma unroll
      for (int gi = 0; gi < 2; ++gi) { const int g = wave * 2 + gi; arL[gi] = ((const GAS float*)P)[SP_ARL + g * 64 + lane]; aiL[gi] = ((const GAS float*)P)[SP_AIL + g * 64 + lane];
          Sp[gi] = (const GAS f32x2*)(F.ws + WS_SSM) + (((size_t)b * SSM_NRUN) * 16 + g) * 64 + lane; }
#pragma unroll 1
      for (int j0 = 0; j0 < r; j0 += 16) {
          f32x2 sv[2][16];
#pragma unroll
          for (int gi = 0; gi < 2; ++gi)
#pragma unroll
              for (int jj = 0; jj < 16; ++jj) { const int j = (j0 + jj < r) ? j0 + jj : r - 1; sv[gi][jj] = Sp[gi][(size_t)j * 1024]; }
#pragma unroll
          for (int jj = 0; jj < 16; ++jj) if (j0 + jj < r) {
#pragma unroll
              for (int gi = 0; gi < 2; ++gi) { const float nr = arL[gi] * xr[gi] - aiL[gi] * xi[gi] + sv[gi][jj].x, ni = arL[gi] * xi[gi] + aiL[gi] * xr[gi] + sv[gi][jj].y; xr[gi] = nr; xi[gi] = ni; } } }
      (void)dvs_; }
    bf16x8 cfr2[2][4];
#pragma unroll
    for (int gi = 0; gi < 2; ++gi)
#pragma unroll
        for (int s = 0; s < 4; ++s) cfr2[gi][s] = *(const GAS bf16x8*)(Cm + ((size_t)((wave * 2 + gi) * 16 + fr)) * 128 + 32 * s + 8 * fq);
    float dvs2[2], gb2[2];
#pragma unroll
    for (int gi = 0; gi < 2; ++gi) { dvs2[gi] = ((const GAS float*)A.in[IN_SD])[l * 256 + (wave * 2 + gi) * 16 + fr]; gb2[gi] = ((const GAS float*)A.in[IN_GLUB])[l * 256 + (wave * 2 + gi) * 16 + fr]; }
    LDS_BAR();
#pragma unroll 1
    for (int sc = 0; sc < 4; ++sc) {
        URaw raw; if (sc < 3) raw = ssm_fetch_u(F, tok0 + (sc + 1) * 32, tid);
#pragma unroll
        for (int gi = 0; gi < 2; ++gi) { const int g = wave * 2 + gi;
            const bf16x8 (&cfr)[4] = cfr2[gi];
            { SsmBu bu; ssm_bu(bu, Ub, g, r32, hi, bfr[gi]);
#pragma unroll
              for (int t = 0; t < 32; ++t) { float t1 = __builtin_fmaf(-ai[gi], xi[gi], SSM_BUR(bu, t)); asm volatile("" : "+v"(t1));
                  const float nr = __builtin_fmaf(ar[gi], xr[gi], t1), ni = __builtin_fmaf(ar[gi], xi[gi], __builtin_fmaf(ai[gi], xr[gi], SSM_BUI(bu, t))); xr[gi] = nr; xi[gi] = ni;
                  *(LAS unsigned*)(Xs + t * XS_STRIDE + 2 * lane) = pkb(nr, ni); } }
            asm volatile("" ::: "memory");
            f32x4 acc[2] = {{0.f, 0.f, 0.f, 0.f}, {0.f, 0.f, 0.f, 0.f}};
#pragma unroll
            for (int s = 0; s < 4; ++s)
#pragma unroll
                for (int tb = 0; tb < 2; ++tb) { const bf16x8 afr = *(const LAS bf16x8*)(Xs + (16 * tb + fr) * XS_STRIDE + 32 * s + 8 * fq); acc[tb] = __builtin_amdgcn_mfma_f32_16x16x32_bf16(afr, cfr[s], acc[tb], 0, 0, 0); }
            const int ch = g * 16 + fr; const float dvs = dvs2[gi];
#pragma unroll
            for (int tb = 0; tb < 2; ++tb)
#pragma unroll
                for (int q = 0; q < 4; q += 2) { const int t = 16 * tb + 4 * fq + q;
                    const float y0 = acc[tb][q] + dvs * bf2f(*(const LAS bf16*)(Ub + t * US_STRIDE + ch * 2)), y1 = acc[tb][q + 1] + dvs * bf2f(*(const LAS bf16*)(Ub + (t + 1) * US_STRIDE + ch * 2));
                    const unsigned pk = pkb(gelu_tanh(y0), gelu_tanh(y1)); Gt[t * GT_STRIDE + ch] = (bf16)(pk & 0xffffu); Gt[(t + 1) * GT_STRIDE + ch] = (bf16)(pk >> 16); }
            asm volatile("" ::: "memory");     }
        bf16x8 w0[8], w1[8];
#pragma unroll
        for (int s = 0; s < 8; ++s) { w0[s] = *(const GAS bf16x8*)(WG + (size_t)(16 * (wave * 2) + fr) * 256 + 32 * s + 8 * fq); w1[s] = *(const GAS bf16x8*)(WG + (size_t)(16 * (wave * 2 + 1) + fr) * 256 + 32 * s + 8 * fq); }
        LDS_BAR();
        if (sc < 3) ssm_store_u(F, raw, tid);
        GAS bf16* MX = (GAS bf16*)(F.ws + WS_MIX) + (size_t)(tok0 + sc * 32) * DM + 768;
#pragma unroll
        for (int nbi = 0; nbi < 2; ++nbi) { const int nb = wave * 2 + nbi; f32x4 acc[2] = {{0.f, 0.f, 0.f, 0.f}, {0.f, 0.f, 0.f, 0.f}};
#pragma unroll
            for (int s = 0; s < 8; ++s) { const bf16x8 bfr = nbi ? w1[s] : w0[s];
#pragma unroll
                for (int tb = 0; tb < 2; ++tb) { const bf16x8 afr = *(const LAS bf16x8*)(Gt + (16 * tb + fr) * GT_STRIDE + 32 * s + 8 * fq); acc[tb] = __builtin_amdgcn_mfma_f32_16x16x32_bf16(afr, bfr, acc[tb], 0, 0, 0); } }
            const int n = 16 * nb + fr; const float gb = gb2[nbi];
#pragma unroll
            for (int tb = 0; tb < 2; ++tb)
#pragma unroll
                for (int q = 0; q < 4; q += 2) { const int t = 16 * tb + 4 * fq + q; const float g0 = bf2f(Gt[t * GT_STRIDE + n]), g1 = bf2f(Gt[(t + 1) * GT_STRIDE + n]);
                    const unsigned pk = pkb(g0 * sigmoidf_(acc[tb][q] + gb), g1 * sigmoidf_(acc[tb][q + 1] + gb)); MX[(size_t)t * DM + n] = (bf16)(pk & 0xffffu); MX[(size_t)(t + 1) * DM + n] = (bf16)(pk >> 16); } }
        LDS_BAR();
    }
}

#ifndef AT_STAGGER
#define AT_STAGGER 1
#endif
#ifndef AT_PIPE
#define AT_PIPE 1
#endif
#ifndef AT_VD
#define AT_VD 3
#endif
constexpr int AT_STAGE = 32768, AT_NS = 4, AT_EX_OFF = 65536;
constexpr float AT_CLAMP = 100.0f, AT_NEG = -1.0e30f;
__device__ __forceinline__ f32x16 mfma32(bf16x8 a, bf16x8 b, f32x16 c) { return __builtin_amdgcn_mfma_f32_32x32x16_bf16(a, b, c, 0, 0, 0); }
__device__ __forceinline__ void glds16(const void* gsrc, unsigned lds_dst) { unsigned keep;
    asm volatile("s_mov_b32 %0, m0\n\ts_mov_b32 m0, %2\n\ts_nop 0\n\tglobal_load_lds_dwordx4 %1, off\n\ts_mov_b32 m0, %0" : "=&s"(keep) : "v"(gsrc), "s"(lds_dst) : "memory"); }
__device__ __forceinline__ void glds16s(const void* sbase, unsigned voff, unsigned lds_dst) { unsigned keep;
    asm volatile("s_mov_b32 %0, m0\n\ts_mov_b32 m0, %3\n\ts_nop 0\n\tglobal_load_lds_dwordx4 %1, %2\n\ts_mov_b32 m0, %0" : "=&s"(keep) : "v"(voff), "s"(sbase), "s"(lds_dst) : "memory"); }
#define AT_WAITBAR(N) asm volatile("s_waitcnt vmcnt(" #N ") lgkmcnt(0)\n\ts_barrier" ::: "memory")
template <int VAR> __device__ __forceinline__ void attn_unit(Frame& F, const ArgsV& A, int l, int b, int h, int qi, bool pre, int nbh) {
    int tid_ = threadIdx.x; asm volatile("" : "+v"(tid_));
    const int tid = tid_, lane = tid & 63, w = __builtin_amdgcn_readfirstlane(tid >> 6), r32 = lane & 31, hi = lane >> 5, map = w >> 2, rg = w & 3;
    const bf16* PR = (const bf16*)(F.ws + WS_PROJ) + (size_t)b * SEQ * NCOLP;
    const int q0 = qi * 128, qw = q0 + rg * 32, nt = 2 * qi + 2;
    LAS unsigned char* lds = F.lds; LAS float* lut = (LAS float*)(lds + LUT_OFF);
    const unsigned lds0 = (unsigned)(uintptr_t)lds;
    const char* kvbase = (const char*)(F.ws + WS_KVH) + ((size_t)((b * 4 + h) * 128) << 15); const unsigned kvoff = (unsigned)(w * 1024 + lane * 16);
    const unsigned dma_base = lds0 + (unsigned)w * 1024u;
#define AT_DMA(j, stoff) do { const char* s_ = kvbase + ((size_t)(j) << 15); const unsigned d_ = (unsigned)__builtin_amdgcn_readfirstlane(dma_base + (stoff)); \
        asm volatile("s_nop 4" ::: "memory");     \
        glds16s(s_, kvoff, d_); glds16s(s_ + 8192, kvoff, d_ + 8192u); glds16s(s_ + 16384, kvoff, d_ + 16384u); glds16s(s_ + 24576, kvoff, d_ + 24576u); } while (0)
    float tv_, lamv_ = 0.f;
    if (tid < 384) { const int rel = tid - 127; tv_ = rel < 0 ? AT_NEG : ((const GAS float*)(F.ws + MS_LUT))[h * 132 + (rel > 128 ? 128 : rel)]; }
    else tv_ = ((const GAS float*)A.in[IN_SUBLN])[l * 128 + (tid - 384)] * ((const GAS float*)(F.ws + MS_LAM))[2 + l];
    if (tid == 0) lamv_ = ((const GAS float*)(F.ws + MS_LAM))[l];
    bf16x8 qf[4];
    { const bf16* qp = PR + (size_t)(qw + r32) * NCOLP + COL_Q + map * 256 + h * 64 + hi * 8;
#pragma unroll
      for (int s = 0; s < 4; ++s) qf[s] = *(const GAS bf16x8*)(qp + 16 * s); }
    float m = 0.f, lsum = 0.f; f32x16 o[4]; const float cfar = ((const GAS float*)(F.ws + MS_LUT))[h * 132 + 128];
    if (!pre) { AT_DMA(0, 0); AT_DMA(1, AT_STAGE); } if (!AT_STAGGER && !AT_PIPE && nt > 2) AT_DMA(2, 2 * AT_STAGE);
    lut[tid] = tv_; if (tid == 0) lut[512] = lamv_;
#pragma unroll
    for (int d = 0; d < 4; ++d)
#pragma unroll
        for (int r = 0; r < 16; ++r) o[d][r] = 0.f;
    const unsigned ksw = (unsigned)((r32 >> 1) & 7);
    const unsigned kb0 = lds0 + (unsigned)map * 8192u + (unsigned)r32 * 128u + ((((unsigned)hi) ^ ksw) << 4);
    const unsigned vq = (unsigned)((lane & 15) >> 2), vchb = (unsigned)(2 * ((lane >> 4) & 1) + ((lane & 3) >> 1)), vsub = (unsigned)((lane & 1) * 8);
    const unsigned va0 = lds0 + 16384u + (4u * hi + vq) * 256u + ((vq << 6) | ((vchb ^ (unsigned)hi) << 4)) + vsub;
    const unsigned vb0 = lds0 + 16384u + (4u * hi + vq + 8u) * 256u + ((vq << 6) | ((vchb ^ ((unsigned)hi + 2u)) << 4)) + vsub;
    f32x16 p0, p1, cinit; v4i16_t vl[16], vh[16]; bf16x8 pf[4], kf[8];
#pragma unroll
    for (int r = 0; r < 16; ++r) cinit[r] = cfar;
#define AT_ST(t) ((unsigned)((t) & 3) * (unsigned)AT_STAGE)
#define AT_KRD(s, kb) (*(const LAS bf16x8*)(uintptr_t)((ka ^ ((unsigned)(s) << 5)) + (kb) * 4096u))
#define AT_VRD(i) do { vl[i] = __builtin_amdgcn_ds_read_tr16_b64_v4i16((LAS v4i16_t*)(uintptr_t)((vaa ^ ((unsigned)((i) & 3) << 6)) + ((i) >> 2) * 4096u)); \
                       vh[i] = __builtin_amdgcn_ds_read_tr16_b64_v4i16((LAS v4i16_t*)(uintptr_t)((vba ^ ((unsigned)((i) & 3) << 6)) + ((i) >> 2) * 4096u)); } while (0)
#if AT_STAGGER
#define AT_SYNC() do { if (j + 1 < nt) AT_WAITBAR(4); else AT_WAITBAR(0); if (j + 2 < nt) AT_DMA(j + 2, AT_ST(j + 2)); } while (0)
#else
#define AT_SYNC() do { if (j + 2 < nt) AT_WAITBAR(4); else AT_WAITBAR(0); } while (0)
#define AT_DMAJ() do { if (VAR != 10 && j + 3 < nt) AT_DMA(j + 3, AT_ST(j + 3)); } while (0)
#endif
#define AT_KADDR(t) unsigned ka; { unsigned stv = AT_ST(t); asm volatile("" : "+v"(stv)); ka = stv + kb0; }
#define AT_QK(t) do { \
        if ((t) >= nt - 4) {                                                            \
            const LAS float* lp = lut + ((qw + r32) - (64 * (t) + 4 * hi) + 68);        \
            _Pragma("unroll") for (int r = 0; r < 16; ++r) { p0[r] = lp[59 - ((r & 3) + 8 * (r >> 2))] - m; p1[r] = lp[27 - ((r & 3) + 8 * (r >> 2))] - m; } \
            _Pragma("unroll") for (int s = 0; s < 4; ++s) { p0 = mfma32(kf[2 * s], qf[s], p0); p1 = mfma32(kf[2 * s + 1], qf[s], p1); } \
        } else {                                                                        \
            if (VAR == 3) { p0 = cinit; p1 = cinit; _Pragma("unroll") for (int s = 0; s < 8; ++s) p0[s] += __builtin_bit_cast(float, (int)kf[s][0]); } else { \
            p0 = mfma32(kf[0], qf[0], cinit); p1 = mfma32(kf[1], qf[0], cinit); \
            _Pragma("unroll") for (int s = 1; s < 4; ++s) { p0 = mfma32(kf[2 * s], qf[s], p0); p1 = mfma32(kf[2 * s + 1], qf[s], p1); } } } \
        __builtin_amdgcn_sched_barrier(0); } while (0)
#define AT_VPRE(t) do { unsigned stv = AT_ST(t); asm volatile("" : "+v"(stv)); vaa = stv + ((VAR == 9) ? (lds0 + 16384u + (unsigned)lane * 8u) : va0); vba = stv + ((VAR == 9) ? (lds0 + 16384u + 2048u + (unsigned)lane * 8u) : vb0); _Pragma("unroll") for (int i_ = 0; i_ < AT_VD; ++i_) AT_VRD(i_); __builtin_amdgcn_sched_barrier(0); } while (0)
#define AT_SM() do { float ps = 0.f; \
        _Pragma("unroll") for (int r = 0; r < 16; ++r) { if (VAR != 1) { p0[r] = __builtin_amdgcn_exp2f(p0[r]); p1[r] = __builtin_amdgcn_exp2f(p1[r]); } ps += p0[r]; ps += p1[r]; }     \
        lsum += ps; AT_DMAJ(); \
        _Pragma("unroll") for (int s = 0; s < 4; ++s) { v4u t_; \
            if (s < 2) { t_.x = pkb(p0[8 * s + 0], p0[8 * s + 1]); t_.y = pkb(p0[8 * s + 2], p0[8 * s + 3]); t_.z = pkb(p0[8 * s + 4], p0[8 * s + 5]); t_.w = pkb(p0[8 * s + 6], p0[8 * s + 7]); } \
            else { const int s2 = s - 2; t_.x = pkb(p1[8 * s2 + 0], p1[8 * s2 + 1]); t_.y = pkb(p1[8 * s2 + 2], p1[8 * s2 + 3]); t_.z = pkb(p1[8 * s2 + 4], p1[8 * s2 + 5]); t_.w = pkb(p1[8 * s2 + 6], p1[8 * s2 + 7]); } \
            pf[s] = __builtin_bit_cast(bf16x8, t_); } \
        __builtin_amdgcn_sched_barrier(0); } while (0)
#define AT_PV(t) AT_PV_(t, true)
#define AT_PV_(t, KPF) do { AT_KADDR((t) + 1); _Pragma("unroll") for (int i = 0; i < 16; ++i) { if (i + AT_VD < 16) AT_VRD(i + AT_VD); \
            if ((KPF) && (i & 1) == 0) kf[i >> 1] = AT_KRD((i >> 2), ((i >> 1) & 1)); \
            const bf16x8 vf = (bf16x8){vl[i][0], vl[i][1], vl[i][2], vl[i][3], vh[i][0], vh[i][1], vh[i][2], vh[i][3]}; \
            o[i & 3] = mfma32(vf, pf[i >> 2], o[i & 3]); __builtin_amdgcn_sched_barrier(0); } } while (0)
#define AT_KLOAD(t) do { AT_KADDR(t); _Pragma("unroll") for (int s = 0; s < 4; ++s) { kf[2 * s] = AT_KRD(s, 0); kf[2 * s + 1] = AT_KRD(s, 1); } } while (0)
#define AT_TILE0() do { float tm = fmaxf(p0[0], p1[0]); \
        _Pragma("unroll") for (int r = 1; r < 16; ++r) tm = fmaxf(tm, fmaxf(p0[r], p1[r])); \
        tm = fmaxf(tm, xchg32(tm, lane)); m = tm; \
        _Pragma("unroll") for (int r = 0; r < 16; ++r) { p0[r] -= tm; p1[r] -= tm; } } while (0)
#if AT_PIPE
    unsigned vaa, vba; int j = 0; f32x16 a0, a1, b0, b1; unsigned pw[16]; float mref = 0.f;
#define AT_PIN(x) asm volatile("" : "+v"(x))
#define AT_SBAR() __builtin_amdgcn_sched_barrier(0)
#define AT_SYNCP(t) do { if ((t) + 1 < nt) AT_WAITBAR(4); else AT_WAITBAR(0); if ((t) + 2 < nt) AT_DMA((t) + 2, AT_ST((t) + 2)); } while (0)
#define AT_EL(X, i) (((i) < 16) ? X##0[(i) & 15] : X##1[(i) & 15])
#define AT_EXP2(X, i) do { if ((i) < 16) X##0[(i) & 15] = __builtin_amdgcn_exp2f(X##0[(i) & 15] - mref); else X##1[(i) & 15] = __builtin_amdgcn_exp2f(X##1[(i) & 15] - mref); } while (0)
#define AT_PHASEA(C, P, t, FILL) do { \
        AT_KADDR(t); bf16x8 kq[8]; \
        _Pragma("unroll") for (int g = 0; g < 4; ++g) kq[g] = AT_KRD((g >> 1), (g & 1)); \
        const bool near_ = (t) >= nt - 4; \
        mref = near_ ? m : m - cfar;                                                    \
        if (near_) { const LAS float* lp = lut + ((qw + r32) - (64 * (t) + 4 * hi) + 68); \
            _Pragma("unroll") for (int r = 0; r < 16; ++r) { C##0[r] = lp[59 - ((r & 3) + 8 * (r >> 2))]; C##1[r] = lp[27 - ((r & 3) + 8 * (r >> 2))]; } } \
        else { _Pragma("unroll") for (int r = 0; r < 16; ++r) { C##0[r] = 0.f; C##1[r] = 0.f; } }     \
        float sacc = 0.f; \
        _Pragma("unroll") for (int g = 0; g < 8; ++g) { if (g + 4 < 8) kq[g + 4] = AT_KRD(((g + 4) >> 1), ((g + 4) & 1)); \
            if ((g & 1) == 0) C##0 = mfma32(kq[g], qf[g >> 1], C##0); else C##1 = mfma32(kq[g], qf[g >> 1], C##1); \
            if (FILL) { sacc += AT_EL(P, 4 * g); sacc += AT_EL(P, 4 * g + 1); sacc += AT_EL(P, 4 * g + 2); sacc += AT_EL(P, 4 * g + 3); AT_PIN(sacc); \
                pw[2 * g] = pkb(AT_EL(P, 4 * g), AT_EL(P, 4 * g + 1)); pw[2 * g + 1] = pkb(AT_EL(P, 4 * g + 2), AT_EL(P, 4 * g + 3)); AT_PIN(pw[2 * g]); AT_PIN(pw[2 * g + 1]); } \
            AT_SBAR(); } \
        if (FILL) lsum += sacc; } while (0)
#define AT_PHASEB(C, FILL) do { \
        _Pragma("unroll") for (int i = 0; i < 16; ++i) { if (i + 3 < 16) AT_VRD(i + 3); \
            const bf16x8 vf = (bf16x8){vl[i][0], vl[i][1], vl[i][2], vl[i][3], vh[i][0], vh[i][1], vh[i][2], vh[i][3]}; \
            const v4u pq = {pw[4 * (i >> 2)], pw[4 * (i >> 2) + 1], pw[4 * (i >> 2) + 2], pw[4 * (i >> 2) + 3]}; \
            o[i & 3] = mfma32(vf, __builtin_bit_cast(bf16x8, pq), o[i & 3]); \
            if (FILL) { AT_EXP2(C, 2 * i); AT_EXP2(C, 2 * i + 1); if (i < 8) AT_PIN(C##0); else AT_PIN(C##1); } \
            AT_SBAR(); } } while (0)
    AT_WAITBAR(4);
    AT_SYNCP(0);
    AT_PHASEA(b, a, 0, false);
    { float tm = fmaxf(b0[0], b1[0]);
#pragma unroll
      for (int r = 1; r < 16; ++r) tm = fmaxf(tm, fmaxf(b0[r], b1[r]));
      tm = fmaxf(tm, xchg32(tm, lane)); m = (nt > 4) ? tm + cfar : tm;
#pragma unroll
      for (int r = 0; r < 16; ++r) { b0[r] = __builtin_amdgcn_exp2f(b0[r] - tm); b1[r] = __builtin_amdgcn_exp2f(b1[r] - tm); } }
#define AT_STEP(C, P, t) do { AT_VPRE((t) - 1); AT_SYNCP(t); AT_PHASEA(C, P, t, true); AT_PHASEB(C, true); } while (0)
#pragma unroll 1
    for (j = 1; j + 1 < nt; j += 2) { AT_STEP(a, b, j); AT_STEP(b, a, j + 1); }
    AT_STEP(a, b, nt - 1);
    { float sacc = 0.f;
#pragma unroll
      for (int r = 0; r < 16; ++r) { sacc += a0[r]; sacc += a1[r]; }
      lsum += sacc;
#pragma unroll
      for (int w2 = 0; w2 < 16; ++w2) pw[w2] = pkb(AT_EL(a, 2 * w2), AT_EL(a, 2 * w2 + 1));
      AT_VPRE(nt - 1); AT_PHASEB(a, false); }
#undef AT_PIN
#undef AT_SBAR
#undef AT_SYNCP
#undef AT_EL
#undef AT_EXP2
#undef AT_PHASEA
#undef AT_PHASEB
#undef AT_STEP
#else
    unsigned vaa, vba; int j = 0;
    if (w >= 4) __builtin_amdgcn_s_setprio(1);
    AT_WAITBAR(4);
    { AT_KADDR(0);
#pragma unroll
      for (int s = 0; s < 4; ++s) { kf[2 * s] = AT_KRD(s, 0); kf[2 * s + 1] = AT_KRD(s, 1); } }
    if (map == 0 || !AT_STAGGER) {
        AT_SYNC(); AT_QK(0); AT_VPRE(0); AT_TILE0(); AT_SM(); AT_PV_(0, !AT_STAGGER);
        { const float cm = cfar - m;
#pragma unroll
          for (int r = 0; r < 16; ++r) cinit[r] = cm; }
#pragma unroll 1
        for (j = 1; j < ((VAR == 11) ? 1 : nt); ++j) { AT_SYNC(); if (VAR == 5 || VAR == 10) continue; if (AT_STAGGER) AT_KLOAD(j); AT_QK(j); if (VAR == 2) { AT_SM(); asm volatile("" :: "v"(pf[0]), "v"(pf[1]), "v"(pf[2]), "v"(pf[3])); AT_KLOAD(j + 1); continue; } if (VAR == 6) { asm volatile("" :: "v"(p0), "v"(p1)); AT_KLOAD(j + 1); continue; } AT_VPRE(j); AT_SM(); AT_PV_(j, !AT_STAGGER); }
    } else {
        AT_SYNC(); AT_QK(0); AT_TILE0(); AT_SM();
        { const float cm = cfar - m;
#pragma unroll
          for (int r = 0; r < 16; ++r) cinit[r] = cm; }
#pragma unroll 1
        for (j = 1; j < nt; ++j) { AT_VPRE(j - 1); AT_SYNC(); AT_PV(j - 1); AT_QK(j); AT_SM(); }
        AT_VPRE(nt - 1); AT_PV(nt - 1);
    }
#endif
#undef AT_ST
#undef AT_KRD
#undef AT_VRD
#undef AT_SYNC
#undef AT_KADDR
#undef AT_QK
#undef AT_VPRE
#undef AT_SM
#undef AT_PV
#undef AT_PV_
#undef AT_KLOAD
#undef AT_TILE0
#undef AT_DMA
    AT_WAITBAR(0);
    __builtin_amdgcn_s_setprio(0);
    if (nbh >= 0) {
        const char* nsrc = (const char*)(F.ws + WS_KVH) + ((size_t)(nbh * 128) << 15) + w * 1024 + lane * 16;
        const unsigned d0_ = (unsigned)__builtin_amdgcn_readfirstlane(dma_base), d1_ = (unsigned)__builtin_amdgcn_readfirstlane(dma_base + AT_STAGE);
        glds16(nsrc, d0_); glds16(nsrc + 8192, d0_ + 8192u); glds16(nsrc + 16384, d0_ + 16384u); glds16(nsrc + 24576, d0_ + 24576u);
        glds16(nsrc + 32768, d1_); glds16(nsrc + 32768 + 8192, d1_ + 8192u); glds16(nsrc + 32768 + 16384, d1_ + 16384u); glds16(nsrc + 32768 + 24576, d1_ + 24576u); }
    lsum += xchg32(lsum, lane);
    const float inv = 1.0f / lsum;
    LAS float* EX = (LAS float*)(lds + AT_EX_OFF) + rg * 4096;
    if (map == 1) { const float lv = lut[512] * inv;
#pragma unroll
        for (int d = 0; d < 4; ++d)
#pragma unroll
            for (int r = 0; r < 16; ++r) EX[(d * 16 + r) * 64 + lane] = o[d][r] * lv; }
    LDS_BAR();
    if (map == 0) { float ss = 0.f;
#pragma unroll
        for (int d = 0; d < 4; ++d) {
#pragma unroll
            for (int r = 0; r < 16; ++r) { const float v = o[d][r] * inv - EX[(d * 16 + r) * 64 + lane]; o[d][r] = v; ss += v * v; }
            __builtin_amdgcn_sched_barrier(0); }
        ss += xchg32(ss, lane);
        const float rn = __builtin_amdgcn_rsqf(ss * (1.0f / 128.0f) + RMS_EPS);
        const LAS float* sg = lut + 384;
        LAS unsigned char* OT = (LAS unsigned char*)EX;
        LDS_WAIT(); asm volatile("" ::: "memory");
#pragma unroll
        for (int d = 0; d < 4; ++d) {
#pragma unroll
            for (int g4 = 0; g4 < 4; ++g4) { const int dd = 32 * d + 8 * g4 + 4 * hi; const f32x4 gg = *(const LAS f32x4*)(sg + dd);
                u32x2g ov; ov.x = pkb(o[d][4 * g4 + 0] * rn * gg.x, o[d][4 * g4 + 1] * rn * gg.y); ov.y = pkb(o[d][4 * g4 + 2] * rn * gg.z, o[d][4 * g4 + 3] * rn * gg.w);
                *(LAS u32x2g*)(OT + r32 * 272 + dd * 2) = ov; }
            __builtin_amdgcn_sched_barrier(0); }
        LDS_WAIT(); asm volatile("" ::: "memory");
        bf16* MXw = (bf16*)(F.ws + WS_MIX) + ((size_t)b * SEQ + qw) * DM + h * 128;
#pragma unroll
        for (int it = 0; it < 8; ++it) { const int row = it * 4 + (lane >> 4), ch = lane & 15; const v4u v = *(const LAS v4u*)(OT + row * 272 + ch * 16); *(GAS v4u*)(MXw + (size_t)row * DM + ch * 8) = v; } }
    LDS_BAR();
}

constexpr int RT_LG_STRIDE = 37;
constexpr int RT_PX_OFF = 19456, RT_CNT_OFF = RT_PX_OFF + 4 * 24 * 64 * 4, RT_W_OFF = RT_CNT_OFF + 512, RT_W_STRIDE = 2064, RT_W_ROWS = 40;
static_assert(4 * 32 * RT_LG_STRIDE * 4 <= RT_PX_OFF && RT_W_OFF + RT_W_ROWS * RT_W_STRIDE <= RING_BYTES, "route LDS");
template <bool DRY> __device__ __forceinline__ void route_unit(Frame& F, const ArgsV& A, int l, int u) {
    UNIT_IDS;
    const int r32 = lane & 31, hi = lane >> 5, rgp = wave & 3, kh = wave >> 2, t0 = u * 128 + rgp * 32;
    LAS float* Lg = (LAS float*)(F.lds) + rgp * 32 * RT_LG_STRIDE; LAS int* cnt = (LAS int*)(F.lds + RT_CNT_OFF); LAS float* PX = (LAS float*)(F.lds + RT_PX_OFF) + rgp * (24 * 64);
    if (tid < 32) cnt[tid] = 0;
    const bf16* xp = (const bf16*)(F.ws + WS_XB) + (size_t)(t0 + r32) * DM + hi * 8 + kh * 512;
    v4u xw[32];
#pragma unroll
    for (int s = 0; s < 32; ++s) xw[s] = *(const GAS v4u*)(xp + 16 * s);
    { const char* wsrc = (const char*)(F.ws + WS_WRT) + (size_t)l * 64 * DM * 2 + lane * 16; const unsigned wl = (unsigned)(uintptr_t)(F.lds + RT_W_OFF);
#pragma unroll
      for (int i = 0; i < 10; ++i) { const int pc = wave * 10 + i, row = pc >> 1, hf = pc & 1; glds16(wsrc + row * 2048 + hf * 1024, (unsigned)__builtin_amdgcn_readfirstlane(wl + row * RT_W_STRIDE + hf * 1024)); } }
    float eb[16], gbv[4];
#pragma unroll
    for (int r = 0; r < 16; ++r) eb[r] = ((const GAS float*)A.in[IN_ERB])[l * 32 + (r & 3) + 8 * (r >> 2) + 4 * hi];
#pragma unroll
    for (int r = 0; r < 4; ++r) gbv[r] = ((const GAS float*)A.in[IN_GRB])[l * 4 + r];
    f32x16 a0, a1; float ss = 0.f;
#pragma unroll
    for (int r = 0; r < 16; ++r) { a0[r] = 0.f; a1[r] = 0.f; }
    asm volatile("s_waitcnt vmcnt(0)" ::: "memory");
    LDS_BAR();
    const LAS unsigned char* wa_p = F.lds + RT_W_OFF + r32 * RT_W_STRIDE + kh * 1024 + hi * 16; const LAS unsigned char* wb_p = F.lds + RT_W_OFF + (32 + (r32 & 7)) * RT_W_STRIDE + kh * 1024 + hi * 16;
#pragma unroll
    for (int s = 0; s < 32; ++s) { const bf16x8 wa = *(const LAS bf16x8*)(wa_p + 32 * s), wb = *(const LAS bf16x8*)(wb_p + 32 * s);
        const bf16x8 xb = __builtin_bit_cast(bf16x8, xw[s]);
        a0 = mfma32(wa, xb, a0); a1 = mfma32(wb, xb, a1);
        ss += bflo(xw[s].x) * bflo(xw[s].x) + bfhi(xw[s].x) * bfhi(xw[s].x) + bflo(xw[s].y) * bflo(xw[s].y) + bfhi(xw[s].y) * bfhi(xw[s].y) + bflo(xw[s].z) * bflo(xw[s].z) + bfhi(xw[s].z) * bfhi(xw[s].z) + bflo(xw[s].w) * bflo(xw[s].w) + bfhi(xw[s].w) * bfhi(xw[s].w); }
    if (kh == 1) {
#pragma unroll
        for (int r = 0; r < 16; ++r) PX[r * 64 + lane] = a0[r];
#pragma unroll
        for (int r = 0; r < 4; ++r) PX[(16 + r) * 64 + lane] = a1[r];
        PX[20 * 64 + lane] = ss; }
    LDS_BAR();
    if (kh == 0) {
#pragma unroll
    for (int r = 0; r < 16; ++r) a0[r] += PX[r * 64 + lane];
#pragma unroll
    for (int r = 0; r < 4; ++r) a1[r] += PX[(16 + r) * 64 + lane];
    ss += PX[20 * 64 + lane];
    ss += xchg32(ss, lane);
    const float rs = __builtin_amdgcn_rsqf(ss * (1.0f / 1024.0f) + RMS_EPS);
#pragma unroll
    for (int r = 0; r < 16; ++r) { const int n = (r & 3) + 8 * (r >> 2) + 4 * hi; Lg[r32 * RT_LG_STRIDE + n] = a0[r] * rs + eb[r]; }
    if (hi == 0) {
#pragma unroll
        for (int r = 0; r < 4; ++r) Lg[r32 * RT_LG_STRIDE + 32 + r] = a1[r] * rs + gbv[r]; }
    LDS_WAIT(); asm volatile("" ::: "memory");
    if (lane < 32) { const LAS float* L = Lg + lane * RT_LG_STRIDE; const int t = t0 + lane;
        int gi = 0; float gm = L[32];
#pragma unroll
        for (int k = 1; k < 4; ++k) { const float v = L[32 + k]; if (v > gm) { gm = v; gi = k; } }
        float gs = 0.f;
#pragma unroll
        for (int k = 0; k < 4; ++k) gs += __expf(L[32 + k] - gm);
        const float gp = 1.0f / gs;
        int i1 = 0; float v1 = L[gi * 8];
#pragma unroll
        for (int k = 1; k < 8; ++k) { const float v = L[gi * 8 + k]; if (v > v1) { v1 = v; i1 = k; } }
        int i2 = -1; float v2 = -3.0e38f;
#pragma unroll
        for (int k = 0; k < 8; ++k) { const float v = L[gi * 8 + k]; if (k != i1 && v > v2) { v2 = v; i2 = k; } }
        const float e2 = __expf(v2 - v1), w1 = 1.0f / (1.0f + e2), w2 = e2 * w1;
        const int e1x = gi * 8 + i1, e2x = gi * 8 + i2;
        ((GAS int*)(F.ws + MS_TOKE))[2 * t] = e1x; ((GAS int*)(F.ws + MS_TOKE))[2 * t + 1] = e2x;
        ((GAS float*)(F.ws + MS_TOKW))[2 * t] = gp * w1; ((GAS float*)(F.ws + MS_TOKW))[2 * t + 1] = gp * w2;
        ((GAS float*)(F.ws + MS_RS2))[t] = rs;
        atomicAdd((int*)&cnt[e1x], 1); atomicAdd((int*)&cnt[e2x], 1); }
    }
    LDS_BAR();
    if (!DRY && tid < 32) { const int c = cnt[tid]; if (c) atomicAdd((unsigned*)(F.ctl + CW_CNT + l * 32 + tid), (unsigned)c); }
    LDS_BAR();
}
__device__ __forceinline__ void slots_unit(Frame& F, int l, int u, int curw) {
    LAS int* pstart = (LAS int*)(F.lds); LAS int* lcnt = pstart + 32; LAS int* lbase = pstart + 64; LAS int* slots = pstart + 128;
    UNIT_IDS;
    const int t = u * 256 + (tid >> 1), k = tid & 1;
    const int e = ((const GAS int*)(F.ws + MS_TOKE))[2 * t + k]; const float rs2v = ((const GAS float*)(F.ws + MS_RS2))[t], tkw = ((const GAS float*)(F.ws + MS_TOKW))[2 * t + k];
    if (wave == 0) {
        const int c = lane < 32 ? (int)__hip_atomic_load(F.ctl + CW_CNT + l * 32 + (lane & 31), RLX_AGENT) : 0; const int padded = ((c + MOEB - 1) / MOEB) * MOEB;
        int incl = padded;
#pragma unroll
        for (int o = 1; o < 32; o <<= 1) { const int v = __builtin_amdgcn_ds_bpermute(((lane - o) & 63) << 2, incl); if (lane >= o) incl += v; }
        if (lane < 32) { pstart[lane] = incl - padded; lcnt[lane] = 0;
            if (u == 0) { const int k = padded / MOEB, nb0 = (incl - padded) / MOEB;
                for (int i = 0; i < k; ++i) ((GAS int*)(F.ctl + CW_BLKE + l * NSLOTB))[nb0 + i] = lane;
                if (lane == 31) *((GAS int*)(F.ctl + CW_NUSED + l)) = incl / MOEB; } } }
    LDS_BAR();
    const int rank = atomicAdd((int*)&lcnt[e], 1);
    LDS_BAR();
    if (tid < 32) { const int c = lcnt[tid]; lbase[tid] = pstart[tid] + (c ? (int)atomicAdd((unsigned*)(F.ctl + curw + tid), (unsigned)c) : 0); }
    LDS_BAR();
    const int slot = lbase[e] + rank;
    slots[tid] = slot;
    ((GAS int*)(F.ws + MS_SLOT))[2 * t + k] = slot;
    ((GAS float*)(F.ws + MS_RSSLOT))[slot] = rs2v;
    ((GAS float*)(F.ws + MS_WSLOT))[slot] = tkw;
    ((GAS int*)(F.ws + MS_TOKSLOT))[slot] = t;
    if (u == 0) { for (int e = tid >> 4; e < NE; e += 32) { const int c = (int)__hip_atomic_load(F.ctl + CW_CNT + l * 32 + e, RLX_AGENT), pad = ((c + MOEB - 1) / MOEB) * MOEB;
            for (int i = c + (tid & 15); i < pad; i += 16) ((int*)(F.ws + MS_TOKSLOT))[pstart[e] + i] = 0; } }
    LDS_BAR();
}
template <bool DRY> __device__ __forceinline__ void combine_rows(Frame& F, const ArgsV& A, bool last) {
    const int gw = F.vcu * 8 + F.wave, NGW = F.G * 8, lane = F.lane;
    const bf16* Y = (const bf16*)(F.ws + WS_Y);
    const int ntk = (NTOK - gw + NGW - 1) / NGW;
    f32x4 fgv[4] = {{0.f, 0.f, 0.f, 0.f}, {0.f, 0.f, 0.f, 0.f}, {0.f, 0.f, 0.f, 0.f}, {0.f, 0.f, 0.f, 0.f}};
    if (last) { const GAS f32x4* fg = (const GAS f32x4*)A.in[IN_FING] + lane;
#pragma unroll
        for (int j = 0; j < 4; ++j) fgv[j] = fg[64 * j]; }
    int sl0 = 0, sl1 = 0; if (lane < ntk) { const int t = gw + lane * NGW; sl0 = ((const GAS int*)(F.ws + MS_SLOT))[2 * t]; sl1 = ((const GAS int*)(F.ws + MS_SLOT))[2 * t + 1]; }
#pragma unroll 1
    for (int i0 = 0; i0 < ntk; i0 += 4) {
        u32x2g xv[4][4], av[4][4], bv[4][4];
#pragma unroll
        for (int q = 0; q < 4; ++q) { const int i = (i0 + q < ntk) ? i0 + q : ntk - 1; const int t = gw + i * NGW;
            const int s0 = (i < 64) ? __builtin_amdgcn_readlane(sl0, i & 63) : ((const GAS int*)(F.ws + MS_SLOT))[2 * t], s1 = (i < 64) ? __builtin_amdgcn_readlane(sl1, i & 63) : ((const GAS int*)(F.ws + MS_SLOT))[2 * t + 1];
            const GAS u32x2g* xb = (const GAS u32x2g*)((const bf16*)(F.ws + WS_XB) + (size_t)t * DM) + lane;
            const GAS u32x2g* y0 = (const GAS u32x2g*)(Y + (size_t)s0 * DM) + lane; const GAS u32x2g* y1 = (const GAS u32x2g*)(Y + (size_t)s1 * DM) + lane;
#pragma unroll
            for (int j = 0; j < 4; ++j) { xv[q][j] = xb[64 * j]; av[q][j] = y0[64 * j]; bv[q][j] = y1[64 * j]; } }
#pragma unroll
        for (int q = 0; q < 4; ++q) if (i0 + q < ntk) { const int t = gw + (i0 + q) * NGW;
            GAS u32x2g* xb = (GAS u32x2g*)((bf16*)(F.ws + WS_XB) + (size_t)t * DM) + lane;
            f32x4 v[4]; float s = 0.f;
#pragma unroll
            for (int j = 0; j < 4; ++j) { const u32x2g x = xv[q][j], a = av[q][j], b = bv[q][j];
                v[j] = (f32x4){bflo(x.x) + bflo(a.x) + bflo(b.x), bfhi(x.x) + bfhi(a.x) + bfhi(b.x), bflo(x.y) + bflo(a.y) + bflo(b.y), bfhi(x.y) + bfhi(a.y) + bfhi(b.y)};
                s += (v[j].x * v[j].x + v[j].y * v[j].y) + (v[j].z * v[j].z + v[j].w * v[j].w); }
            s = wave_sum(s);
            if (DRY) { if (s == 123.456f) ((float*)(F.ws + MS_ROWSS))[t] = s; }
            else if (!last) {
#pragma unroll
                for (int j = 0; j < 4; ++j) { u32x2g o; o.x = pkb(v[j].x, v[j].y); o.y = pkb(v[j].z, v[j].w); xb[64 * j] = o; }
                if (lane == 0) ((GAS float*)(F.ws + MS_ROWSS))[t] = s;
            } else { const float rs = __builtin_amdgcn_rsqf(s * (1.0f / 1024.0f) + RMS_EPS);
                GAS f32x4* xr = (GAS f32x4*)(F.out + (size_t)t * DM) + lane;
#pragma unroll
                for (int j = 0; j < 4; ++j) xr[64 * j] = v[j] * rs * fgv[j]; } }
    }
}
constexpr int PH_PER_LAYER = 9, N_PHASES = 1 + DEPTH * PH_PER_LAYER;
#ifndef MK_ONE_LAUNCH
#define MK_ONE_LAUNCH 1
#endif
#ifndef MK_CG_SYNC
#define MK_CG_SYNC 0
#endif
__global__ void __launch_bounds__(512, 2) hymba_fwd(Args args) {
    extern __shared__ __attribute__((aligned(16))) unsigned char lds_raw[];
    Frame F;
    F.lds = (LAS unsigned char*)lds_raw;
    F.MISC = (volatile LAS unsigned*)(F.lds + MISC_OFF);
    F.tid = threadIdx.x; F.lane = F.tid & 63; F.wave = __builtin_amdgcn_readfirstlane(F.tid >> 6);
    F.G = gridDim.x; { const int bx = blockIdx.x; F.vcu = (F.G % 8 == 0) ? (bx % 8) * (F.G / 8) + bx / 8 : bx; }
    F.ws = args.ws; F.out = args.out; F.ctl = (gu32*)(args.ws + WS_CTL);
    for (int u = F.tid; u < (LDS_BYTES - LDSCTL_OFF) / 4; u += 512) ((LAS unsigned*)(F.lds + LDSCTL_OFF))[u] = 0u;
    __syncthreads();
    const int lo = args.ph_lo, hi = args.ph_hi;
    const bool fused = (hi - lo) > 1;
    XcdBarrier bar; bar.bar = (unsigned*)(F.ctl + CW_BAR); bar.x = 0; bar.st = nullptr;
    if (fused) bar = xcd_barrier_post((unsigned*)(F.ctl + CW_BAR), F.MISC + 8);
    if (threadIdx.x == 0) __hip_atomic_store(F.ctl + CW_XCC + F.vcu, xb_xcc_id() + 1u, RLX_AGENT);
#ifndef ONLY_T
#define ONLY_T -1
#endif
#define PH_EN(t) (ONLY_T < 0 || ONLY_T == (t))
#ifndef DUP_T
#define DUP_T -1
#endif
#ifndef PROBE_VAR
#define PROBE_VAR 0
#endif
#define REP(t) for (int rep_ = 0; rep_ < ((DUP_T == (t) && l == 0) ? 2 : 1); ++rep_)
#define IN(k) (lo <= (k) && (k) < hi)
#define REFRESH() do { int t_ = threadIdx.x; asm volatile("" : "+v"(t_)); F.tid = t_; F.lane = t_ & 63; F.wave = __builtin_amdgcn_readfirstlane(t_ >> 6); asm volatile("" : "+s"(F.ws), "+s"(F.out), "+s"(F.ctl)); } while (0)
#define SEAM(k) do { if (IN(k) && IN((k) + 1)) { xcd_barrier(bar); if (DUP_T == 10) xcd_barrier(bar); } } while (0)
    for (int rep0_ = 0; rep0_ < (DUP_T == 0 ? 2 : 1); ++rep0_) if (PH_EN(0) && IN(0)) { REFRESH(); p0_prologue(F, args_view()); }
#if MK_CG_SYNC
    if (fused && IN(0)) { cg::this_grid().sync(); }
    else SEAM(0);
#else
    SEAM(0);
#endif
#pragma unroll 1
    for (int l = 0; l < DEPTH; ++l) {
        const int pb = 1 + l * PH_PER_LAYER;
        REP(1) if (PH_EN(1) && IN(pb + 0)) { REFRESH(); unsigned char* ws = F.ws;
            pg8::Gemm g{(const pg8::bf16_t*)(ws + WS_XB), (const pg8::bf16_t*)(ws + WS_WIN) + (size_t)l * NCOL * DM, NTOK, NCOL, DM, 0, nullptr, (const float*)(ws + MS_ROWSS), (unsigned)(uintptr_t)(F.lds + SCAL_OFF)};
            pg8::StaticOrder S; S.init(NTOK, NCOL, F.G, (int)blockIdx.x);
            pg8::EpiProj E{(pg8::bf16_t*)(ws + WS_PROJ), (pg8::bf16_t*)(ws + WS_KVH), (const LAS float*)(F.lds + SCAL_OFF)};
            pg8::gemm_phase<pg8::EpiProj, pg8::StaticOrder, true, true>(F.lds + RING_OFF, g, S, E);
            if (F.G == 256 && (int)blockIdx.x >= 128) { pg8::Unit uu; int pm6 = -1;
                for (int i = 0; i < 4; ++i) if (S.next(i, uu) && uu.pn == 6) pm6 = uu.pm;
                if (pm6 >= 0) { const int u0 = (pm6 >> 5) * SSM_NRUN + (pm6 & 31) * 2; ssmA_unit(F, l, u0); ssmA_unit(F, l, u0 + 1); } }
        }
        SEAM(pb + 0);
        REP(2) if (PH_EN(2) && IN(pb + 1) && F.G != 256) { REFRESH();
            for (int u = F.vcu; u < NB * SSM_NRUN; u += F.G) ssmA_unit(F, l, u);
            const ArgsV av = args_view();
            for (int u = F.vcu; u < NB * 128; u += F.G) conv_unit(F, av, l, u);
        }
        if (F.G != 256) SEAM(pb + 1);
        REP(3) if (PH_EN(3) && IN(pb + 2)) { REFRESH(); const ArgsV av = args_view();
#ifndef PROBE_VAR
#define PROBE_VAR 0
#endif
            const bool probe_pass = (DUP_T == 3 && PROBE_VAR != 0 && l == 0 && rep_ == 0);
            if (F.G == 256 && !probe_pass) for (int u = F.vcu; u < NB * 128; u += F.G) conv_unit(F, av, l, u);
            if (!probe_pass || PROBE_VAR == 8) for (int u = F.vcu; u < NB * SSM_NRUN; u += F.G) ssmC_unit(F, av, l, u);
#ifndef NO_ATTN
            if (probe_pass && PROBE_VAR == 8) {} else {
                const bool bal = (F.G == 256); const int xg = F.vcu >> 5, s = F.vcu & 31; const int nu = bal ? 4 : (1024 - F.vcu + F.G - 1) / F.G;
#pragma unroll 1
                for (int i = 0; i < nu; ++i) { int bh, qi, nbh; bool pre;
                    if (bal) { bh = 2 * xg + (i >> 1); qi = (i & 1) ? 63 - s : s; nbh = (i < 3) ? 2 * xg + ((i + 1) >> 1) : -1; pre = i > 0; }
                    else { const int u = F.vcu + i * F.G; bh = u >> 6; qi = 63 - (u & 63); nbh = -1; pre = false; }
#if PROBE_VAR != 0 && PROBE_VAR != 8
                    if (probe_pass) { attn_unit<PROBE_VAR>(F, av, l, bh >> 2, bh & 3, qi, pre, nbh); continue; }
#endif
                    attn_unit<0>(F, av, l, bh >> 2, bh & 3, qi, pre, nbh); } }
#endif
        }
        SEAM(pb + 2);
        REP(4) if (PH_EN(4) && IN(pb + 3)) { REFRESH(); unsigned char* ws = F.ws;
            pg8::Gemm g{(const pg8::bf16_t*)(ws + WS_MIX), (const pg8::bf16_t*)(ws + WS_WOUT) + (size_t)l * DM * DM, NTOK, DM, DM, 0, nullptr, nullptr, 0u};
            pg8::StaticOrder S; S.init(NTOK, DM, F.G, (int)blockIdx.x);
            pg8::EpiResid E{(pg8::bf16_t*)(ws + WS_XB), (DUP_T == 4 && l == 0 && rep_ == 0) ? (pg8::bf16_t*)(ws + WS_KVH) : (pg8::bf16_t*)(ws + WS_XB)};
            pg8::gemm_phase<pg8::EpiResid, pg8::StaticOrder, true, true>(F.lds + RING_OFF, g, S, E);
            if (F.G == 256 && DUP_T != 4) { pg8::Unit u0, u1; (void)S.next(0, u0); (void)S.next(1, u1); const int bx = (int)blockIdx.x, pnm = bx >> 6, pmr = (pnm < 2) ? u0.pm : u1.pm;
                if (threadIdx.x == 0) { gu32* xt = F.ctl + CW_XCC; gu32* rt = F.ctl + CW_RT + l * 128; const unsigned myx = xb_xcc_id(); bool homo = true;
                    unsigned xv_[4];
#pragma unroll
                    for (int j = 0; j < 4; ++j) { const int b2 = (bx & 63) + 64 * j; xv_[j] = __hip_atomic_load(xt + (b2 % 8) * 32 + b2 / 8, RLX_AGENT); }
                    homo = (xv_[0] == myx + 1u) & (xv_[1] == myx + 1u) & (xv_[2] == myx + 1u) & (xv_[3] == myx + 1u);
                    if (!homo) { __builtin_amdgcn_fence(__ATOMIC_RELEASE, "agent"); VM_WAIT(); }
                    (void)__hip_atomic_fetch_add(rt + u0.pm, 1u, RLX_AGENT); (void)__hip_atomic_fetch_add(rt + u1.pm, 1u, RLX_AGENT);
                    pg8::DownOrder::poll_ge(rt + pmr, 4u);
                    __builtin_amdgcn_fence(__ATOMIC_ACQUIRE, "agent"); VM_WAIT(); }
                __syncthreads();
                route_unit<false>(F, args_view(), l, 2 * pmr + (pnm & 1)); }
        }
        if (F.G != 256 || DUP_T == 4) SEAM(pb + 3);
        REP(5) if (PH_EN(5) && IN(pb + 4) && (F.G != 256 || DUP_T == 4)) { REFRESH(); for (int u = F.vcu; u < NTOK / 128; u += F.G) { if (DUP_T == 5 && l == 0 && rep_ == 0) route_unit<true>(F, args_view(), l, u); else route_unit<false>(F, args_view(), l, u); } }
        SEAM(pb + 4);
        REP(6) if (PH_EN(6) && IN(pb + 5)) { REFRESH(); for (int u = F.vcu; u < NTOK / 256; u += F.G) slots_unit(F, l, u, (DUP_T == 6 && l == 0 && rep_ == 0) ? CW_CUR + 1024 : CW_CUR + l * 32);
            convert_items(F, args_view(), 2 * (1152 + 512 + 32) + l * NE * 768, 2 * (1152 + 512 + 32) + (l + 1) * NE * 768); }
        SEAM(pb + 5);
        REP(7) if (PH_EN(7) && IN(pb + 6)) { REFRESH(); unsigned char* ws = F.ws;
            const int n_used = (int)__hip_atomic_load(F.ctl + CW_NUSED + l, RLX_AGENT);
            gu32* qd = F.ctl + CW_GUD + ((DUP_T == 7 && l == 0 && rep_ == 0) ? 2 : l) * 4096;
            { pg8::Gemm g{(const pg8::bf16_t*)(ws + WS_XB), (const pg8::bf16_t*)(ws + WS_WGU) + (size_t)l * NE * 1024 * 1024, PSLOTS, 1024, DM, (size_t)1024 * 1024 * 2, (const int*)(ws + MS_TOKSLOT), (const float*)(ws + MS_RSSLOT), (unsigned)(uintptr_t)(F.lds + SCAL_OFF)};
              pg8::GroupedOrder S; S.init(n_used, 4, F.G, F.vcu, (const int*)(F.ctl + CW_BLKE + l * NSLOTB));
              pg8::EpiGateUp E{(pg8::bf16_t*)(ws + WS_ACT), (const LAS float*)(F.lds + SCAL_OFF)};
              pg8::gemm_phase<pg8::EpiGateUp, pg8::GroupedOrder, true, true, true>(F.lds + RING_OFF, g, S, E); }
            VM_WAIT(); __syncthreads();
            if (F.wave == 0) { const unsigned myx = xb_xcc_id(); const int q = F.vcu >> 2, r_ = (n_used * 4) % F.G; gu32* xt = F.ctl + CW_XCC;
                unsigned xq_[4];
#pragma unroll
                for (int k = 0; k < 4; ++k) xq_[k] = __hip_atomic_load(xt + q * 4 + k, RLX_AGENT);
                const bool homo = (xq_[0] == myx + 1u) & (xq_[1] == myx + 1u) & (xq_[2] == myx + 1u) & (xq_[3] == myx + 1u);
                int na = 0;
                for (int cc = F.lane; cc < r_; cc += 64) na += (__hip_atomic_load(xt + cc, RLX_AGENT) == myx + 1u) ? 1 : 0;
                na = (int)(wave_sum((float)na) + 0.5f);
                if (F.lane == 0) {
                    if (!homo) { __builtin_amdgcn_fence(__ATOMIC_RELEASE, "agent"); VM_WAIT(); }
                    if (F.vcu < r_) { const unsigned old_ = __hip_atomic_fetch_add(qd + myx * 64 + 16, 1u, RLX_AGENT);
                        if ((int)old_ + 1 == na) { __builtin_amdgcn_fence(__ATOMIC_RELEASE, "agent"); VM_WAIT(); __hip_atomic_store(qd + myx * 64 + 17, 1u, RLX_AGENT); } }
                    (void)__hip_atomic_fetch_add(qd + q * 64, 1u, RLX_AGENT);
                    pg8::DownOrder::poll_ge(qd + q * 64, 4u);
                    __builtin_amdgcn_fence(__ATOMIC_ACQUIRE, "agent"); VM_WAIT(); } }
            __syncthreads();
            { pg8::Gemm g{(const pg8::bf16_t*)(ws + WS_ACT), (const pg8::bf16_t*)(ws + WS_WDN) + (size_t)l * NE * DM * FF, PSLOTS, DM, FF, (size_t)DM * FF * 2, nullptr, (const float*)(ws + MS_WSLOT), (unsigned)(uintptr_t)(F.lds + SCAL_OFF)};
              pg8::DownOrder S; S.init(n_used, F.G, F.vcu, (const int*)(F.ctl + CW_BLKE + l * NSLOTB), qd, F.ctl + CW_XCC);
              pg8::EpiDown E{(pg8::bf16_t*)(ws + WS_Y), (const LAS float*)(F.lds + SCAL_OFF)};
              pg8::gemm_phase<pg8::EpiDown, pg8::DownOrder, true, true>(F.lds + RING_OFF, g, S, E); }
        }
        SEAM(pb + 7);
        REP(9) if (PH_EN(9) && IN(pb + 8)) { REFRESH(); if (DUP_T == 9 && l == 0 && rep_ == 0) combine_rows<true>(F, args_view(), false); else combine_rows<false>(F, args_view(), l == DEPTH - 1); }
        SEAM(pb + 8);
    }
#undef IN
#undef SEAM
}

extern "C" void kernel_launch(void* const* d_in, const int* in_sizes, int n_in, void* d_out, int out_size, void* d_ws, size_t ws_size, hipStream_t stream) {
    static int grid = 0;
    if (grid == 0) {
        if (n_in != N_IN || in_sizes[0] != NTOK * DM || out_size != NTOK * DM || ws_size < WS_END) { fprintf(stderr, "kernel_launch: unexpected shapes (n_in %d, in0 %d, out %d, ws %zu)\n", n_in, n_in > 0 ? in_sizes[0] : -1, out_size, ws_size); grid = -1; return; }
        int dev = 0, cus = 0, per_cu = 0;
        if (hipGetDevice(&dev) != hipSuccess || hipDeviceGetAttribute(&cus, hipDeviceAttributeMultiprocessorCount, dev) != hipSuccess) { grid = -1; return; }
        if (hipFuncSetAttribute((const void*)hymba_fwd, hipFuncAttributeMaxDynamicSharedMemorySize, LDS_BYTES) != hipSuccess) { fprintf(stderr, "kernel_launch: hipFuncSetAttribute failed\n"); grid = -1; return; }
        if (hipOccupancyMaxActiveBlocksPerMultiprocessor(&per_cu, (const void*)hymba_fwd, 512, LDS_BYTES) != hipSuccess || per_cu < 1) { fprintf(stderr, "kernel_launch: occupancy query says %d blocks per CU\n", per_cu); (void)hipGetLastError(); grid = -1; return; }
        grid = cus;
    }
    if (grid < 0) return;
    (void)hipMemsetAsync((char*)d_ws + WS_CTL, 0, CTL_ZERO_BYTES, stream);
    Args a{};
    for (int i = 0; i < N_IN; ++i) a.in[i] = (const float*)d_in[i];
    a.out = (float*)d_out; a.ws = (unsigned char*)d_ws;
#if MK_ONE_LAUNCH
    a.ph_lo = 0; a.ph_hi = N_PHASES;
    void* kargs[] = {&a};
    hipError_t e = hipLaunchCooperativeKernel((const void*)hymba_fwd, dim3(grid), dim3(512), kargs, LDS_BYTES, stream);
    if (e != hipSuccess) fprintf(stderr, "kernel_launch: cooperative launch failed: %s (grid %d)\n", hipGetErrorString(e), grid);
#else
    for (int p = 0; p < N_PHASES; ++p) { a.ph_lo = p; a.ph_hi = p + 1; hipLaunchKernelGGL(hymba_fwd, dim3(grid), dim3(512), LDS_BYTES, stream, a); }
#endif
}
```
